# Optimizing an MI355X kernel written in HIP

```python
import jax, jax.numpy as jnp
from jax import lax
import numpy as np

D_MODEL = 2048
BATCH = 8
SEQ = 2048
DEPTH = 1

MIX_WIDTH = D_MODEL
POOL_WIDTH = MIX_WIDTH // 2
N_POOL_GROUPS = 4
POOL_GROUP_DIM = POOL_WIDTH // N_POOL_GROUPS
POOL_WINDOWS = (2, 4, 8, 16)
RET_WIDTH = MIX_WIDTH - POOL_WIDTH
RET_HEADS = 8
RET_HEAD_DIM = RET_WIDTH // RET_HEADS
RET_CHUNK = 128
ROPE_BASE = 10000.0
IN_COLS = POOL_WIDTH + 4 * RET_WIDTH
D_FF = 5504
CONV_WIDTH = 3
PLE_DIM = 256
NORM_EPS = 1e-6
GN_EPS = 1e-5

kernel_name = "hybrid_pool_retention_convffn_ple"


def rmsnorm(x, w):
    xf = x.astype(jnp.float32)
    y = xf * lax.rsqrt(jnp.mean(xf * xf, axis=-1, keepdims=True) + NORM_EPS)
    return (y * w.astype(jnp.float32)).astype(x.dtype)


def pool_mixer(u, pool_w, pool_scale):
    b, s, _ = u.shape
    ug = u.reshape(b, s, N_POOL_GROUPS, POOL_GROUP_DIM)
    cs = jnp.cumsum(ug.astype(jnp.float32), axis=1)
    cs = jnp.pad(cs, ((0, 0), (1, 0), (0, 0), (0, 0)))
    t = jnp.arange(s)
    means = []
    for g, w in enumerate(POOL_WINDOWS):
        lo = jnp.maximum(t + 1 - w, 0)
        cnt = (t + 1 - lo).astype(jnp.float32)
        win = cs[:, 1:, g] - cs[:, lo, g]
        means.append(win / cnt[None, :, None])
    mean = jnp.stack(means, axis=2).astype(u.dtype)
    y = jnp.einsum('bsgc,gcd->bsgd', mean - ug, pool_w)
    return y.reshape(b, s, POOL_WIDTH) * pool_scale


def rotary(x, cos, sin):
    x1, x2 = jnp.split(x, 2, axis=-1)
    c = cos[None, :, None, :]
    s_ = sin[None, :, None, :]
    return jnp.concatenate([x1 * c - x2 * s_, x2 * c + x1 * s_], axis=-1)


def retention_chunkwise(q, k, v):
    b, s, h, dk = q.shape
    dv = v.shape[-1]
    n = s // RET_CHUNK
    C = RET_CHUNK
    qc = q.reshape(b, n, C, h, dk)
    kc = k.reshape(b, n, C, h, dk)
    vc = v.reshape(b, n, C, h, dv)
    gamma = 1.0 - jnp.exp2(-5.0 - jnp.arange(h, dtype=jnp.float32))
    log_g = jnp.log(gamma)
    idx = jnp.arange(C, dtype=jnp.float32)
    diff = idx[:, None] - idx[None, :]
    decay = jnp.where(diff[None] >= 0,
                      jnp.exp(jnp.maximum(diff, 0.0)[None] * log_g[:, None, None]),
                      0.0)
    scores = jnp.einsum('bnihd,bnjhd->bnhij', qc, kc) * decay
    intra = jnp.einsum('bnhij,bnjhe->bnihe', scores, vc)
    zeta = jnp.exp((C - 1.0 - idx)[None, :] * log_g[:, None])
    kv = jnp.einsum('bnjhd,hj,bnjhe->nbhde', kc, zeta, vc)
    g_chunk = jnp.exp(C * log_g)[:, None, None]

    def step(state, kv_i):
        return g_chunk * state + kv_i, state

    init = jnp.zeros((b, h, dk, dv), dtype=kv.dtype)
    _, r_prev = lax.scan(step, init, kv)
    xi = jnp.exp((idx + 1.0)[None, :] * log_g[:, None])
    cross = jnp.einsum('bnihd,nbhde,hi->bnihe', qc, r_prev, xi)
    return (intra + cross).reshape(b, s, h, dv).astype(q.dtype)


def head_groupnorm(y, w):
    yf = y.astype(jnp.float32)
    mu = jnp.mean(yf, axis=-1, keepdims=True)
    var = jnp.mean(jnp.square(yf - mu), axis=-1, keepdims=True)
    return ((yf - mu) * lax.rsqrt(var + GN_EPS) * w.astype(jnp.float32)).astype(y.dtype)


def causal_dwconv(x, w, bias):
    s = x.shape[1]
    xp = jnp.pad(x, ((0, 0), (CONV_WIDTH - 1, 0), (0, 0)))
    out = bias
    for j in range(CONV_WIDTH):
        out = out + xp[:, j:j + s] * w[j]
    return out


def setup_inputs(seed: int = 0) -> dict:
    key = jax.random.key(seed)
    ks = jax.random.split(key, 20)
    f32 = jnp.float32
    nrm = lambda k, shape, scale: jax.random.normal(k, shape, f32) * scale
    return {
        "x": nrm(ks[0], (BATCH, SEQ, D_MODEL), 1.0),
        "p": nrm(ks[1], (DEPTH, BATCH, SEQ, PLE_DIM), 1.0),
        "norm1_w": 1.0 + nrm(ks[2], (DEPTH, D_MODEL), 0.05),
        "w_in": nrm(ks[3], (DEPTH, D_MODEL, IN_COLS), D_MODEL ** -0.5),
        "pool_w": nrm(ks[4], (DEPTH, N_POOL_GROUPS, POOL_GROUP_DIM, POOL_GROUP_DIM), POOL_GROUP_DIM ** -0.5),
        "pool_scale": 1.0 + nrm(ks[5], (DEPTH, POOL_WIDTH), 0.1),
        "ret_gn_w": 1.0 + nrm(ks[6], (DEPTH, RET_WIDTH), 0.05),
        "w_out": nrm(ks[7], (DEPTH, MIX_WIDTH, D_MODEL), MIX_WIDTH ** -0.5),
        "norm2_w": 1.0 + nrm(ks[8], (DEPTH, D_MODEL), 0.05),
        "w_up": nrm(ks[9], (DEPTH, D_MODEL, 2 * D_FF), D_MODEL ** -0.5),
        "conv_w": nrm(ks[10], (DEPTH, CONV_WIDTH, 2 * D_FF), CONV_WIDTH ** -0.5),
        "conv_b": nrm(ks[11], (DEPTH, 2 * D_FF), 0.02),
        "w_down": nrm(ks[12], (DEPTH, D_FF, D_MODEL), D_FF ** -0.5),
        "norm3_w": 1.0 + nrm(ks[13], (DEPTH, D_MODEL), 0.05),
        "ple_gate_w": nrm(ks[14], (DEPTH, D_MODEL, D_MODEL), D_MODEL ** -0.5),
        "ple_proj_w": nrm(ks[15], (DEPTH, PLE_DIM, D_MODEL), PLE_DIM ** -0.5),
        "final_norm_w": 1.0 + nrm(ks[16], (D_MODEL,), 0.05),
    }


def reference(x, p, norm1_w, w_in, pool_w, pool_scale, ret_gn_w, w_out, norm2_w,
              w_up, conv_w, conv_b, w_down, norm3_w, ple_gate_w, ple_proj_w, final_norm_w):
    b, s, _ = x.shape
    pos = jnp.arange(s, dtype=jnp.float32)
    inv_freq = 1.0 / (ROPE_BASE ** (jnp.arange(0, RET_HEAD_DIM, 2, dtype=jnp.float32) / RET_HEAD_DIM))
    ang = pos[:, None] * inv_freq[None, :]
    cos = jnp.cos(ang).astype(x.dtype)
    sin = jnp.sin(ang).astype(x.dtype)
    k_scale = RET_HEAD_DIM ** -0.5
    splits = [POOL_WIDTH, POOL_WIDTH + RET_WIDTH, POOL_WIDTH + 2 * RET_WIDTH, POOL_WIDTH + 3 * RET_WIDTH]

    h = x
    for i in range(DEPTH):
        a = rmsnorm(h, norm1_w[i])
        z = a @ w_in[i]
        u, q, k, v, g = jnp.split(z, splits, axis=-1)
        pool_out = pool_mixer(u, pool_w[i], pool_scale[i])
        q = rotary(q.reshape(b, s, RET_HEADS, RET_HEAD_DIM), cos, sin)
        k = rotary(k.reshape(b, s, RET_HEADS, RET_HEAD_DIM), cos, sin) * k_scale
        v = v.reshape(b, s, RET_HEADS, RET_HEAD_DIM)
        r = retention_chunkwise(q, k, v)
        r = head_groupnorm(r, ret_gn_w[i].reshape(RET_HEADS, RET_HEAD_DIM)).reshape(b, s, RET_WIDTH)
        r = jax.nn.silu(g) * r
        h = h + jnp.concatenate([pool_out, r], axis=-1) @ w_out[i]
        c = rmsnorm(h, norm2_w[i])
        up = causal_dwconv(c @ w_up[i], conv_w[i], conv_b[i])
        gate, val = jnp.split(up, 2, axis=-1)
        h = h + (jax.nn.silu(gate) * val) @ w_down[i]
        e = rmsnorm(h, norm3_w[i])
        h = h + jax.nn.sigmoid(e @ ple_gate_w[i]) * (p[i] @ ple_proj_w[i])
    return rmsnorm(h, final_norm_w)
```

```cpp
#include <hip/hip_runtime.h>
#include <hip/hip_cooperative_groups.h>
#include <cmath>
#include <cstdio>
#include <cstring>
namespace cg = cooperative_groups;

#ifndef PHMASK
#define PHMASK 0xfff
#endif
#ifndef MK_SINGLE
#define MK_SINGLE 1
#endif

#define LAS __attribute__((address_space(3)))
typedef unsigned short bf16_t;
typedef short bf16x8 __attribute__((ext_vector_type(8)));
typedef float f32x4 __attribute__((ext_vector_type(4)));
typedef unsigned u32x4 __attribute__((ext_vector_type(4)));
typedef unsigned u32x2 __attribute__((ext_vector_type(2)));

constexpr int NTOK = 16384, DM = 2048, SEQ = 2048, INC = 5120, DFF = 5504, UPC = 11008, PLE = 256;
constexpr float NORM_EPS = 1e-6f, GN_EPS = 1e-5f;
constexpr size_t MiB = 1048576;
constexpr size_t OFF_WIN = 0, OFF_WPROJ = 20 * MiB, OFF_POOLT = 21 * MiB, OFF_WOUT = 22 * MiB, OFF_WUP = 30 * MiB,
                 OFF_WDOWN = 73 * MiB, OFF_WGATE = 95 * MiB, OFF_SUMSQ = 103 * MiB, OFF_COS = 103 * MiB + 262144,
                 OFF_SIN = OFF_COS + 524288, OFF_BAR = 104 * MiB + 524288, OFF_PB = 105 * MiB,
                 OFF_XB = 113 * MiB, OFF_Z = 177 * MiB, OFF_DIFF = 337 * MiB, OFF_KVT = 369 * MiB  , OFF_RT = 401 * MiB,
                 OFF_MIX = 433 * MiB, OFF_H1B = 177 * MiB, OFF_ACT = 241 * MiB, OFF_EDGE = 413 * MiB,
                 OFF_H2B = 113 * MiB, OFF_PROJ = 448 * MiB, OFF_H3B = 177 * MiB;
constexpr int LDS_BYTES = 131072 + 16384;
constexpr int EPI_LDS = 131072;

struct Params {
    const float *x, *p, *norm1_w, *w_in, *pool_w, *pool_scale, *ret_gn_w, *w_out, *norm2_w, *w_up, *conv_w, *conv_b, *w_down,
        *norm3_w, *ple_gate_w, *ple_proj_w, *final_norm_w;
    float* out;
    unsigned char* ws;
    float inv_freq[64];
    float log2g[8];
    int ph_lo, ph_hi;
};

typedef __bf16 bf16x2_t __attribute__((ext_vector_type(2)));
typedef float f32x2_t __attribute__((ext_vector_type(2)));
__device__ __forceinline__ unsigned cvt_pk_bf16(float lo, float hi) { const f32x2_t v = {lo, hi}; return __builtin_bit_cast(unsigned, __builtin_convertvector(v, bf16x2_t)); }
__device__ __forceinline__ float bflo(unsigned w) { return __uint_as_float(w << 16); }
__device__ __forceinline__ float bfhi(unsigned w) { return __uint_as_float(w & 0xffff0000u); }
__device__ __forceinline__ float sigmoidf_(float v) { return __builtin_amdgcn_rcpf(1.0f + __expf(-v)); }
template <int CTRL> __device__ __forceinline__ float dpp_f(float v) { return __builtin_bit_cast(float, __builtin_amdgcn_update_dpp(0, __builtin_bit_cast(int, v), CTRL, 0xf, 0xf, true)); }
__device__ __forceinline__ float wave_sum(float s) {
    s += __shfl_xor(s, 32); s += __shfl_xor(s, 16); s += __shfl_xor(s, 8); s += __shfl_xor(s, 4); s += __shfl_xor(s, 2); s += __shfl_xor(s, 1); return s;
}

namespace pg8 {
constexpr int BM = 256, BK = 64, HALF = 128, HTB = HALF * BK * 2, NXCD = 8, WGM = 8;
__device__ __forceinline__ int lds_byte(int r, int c) { const int st = (r >> 4) * 2 + (c >> 5), rr = r & 15, cc = c & 31, ob = rr * 64 + cc * 2; return st * 1024 + (ob ^ (((ob >> 9) & 1) << 5)); }
__device__ __forceinline__ void stage_rc(int b, int& R, int& C) { const int st = b / 1024, sb = b % 1024, swz = sb ^ (((sb >> 9) & 1) << 5); R = (st >> 1) * 16 + swz / 64; C = (st & 1) * 32 + (swz % 64) / 2; }
__device__ __forceinline__ int perm32(int rho) { const int n = rho >> 4, i = rho & 15; return 8 * (i >> 2) + 4 * n + (i & 3); }
__device__ __forceinline__ int perm32b(int rho) { const int n = rho >> 4, i = rho & 15, q = i >> 2; return 16 * n + 8 * (q & 1) + 4 * (q >> 1) + (i & 3); }

struct Unit { int pm, pn; };
struct Gemm { const bf16_t* A; const bf16_t* Bt; int M, N, K, lda, ldb, a_pn_off; };

struct StaticOrder {
    int nM, nN, nwg, G, c;
    __device__ void init(int M, int N, int G_, int c_) { nM = M / BM; nN = N / BM; nwg = nM * nN; G = G_; c = c_; }
    __device__ bool next(int i, Unit& u) const {
        const long L = (long)i * G + c; if (L >= nwg) return false;
        int wgid = (int)L; { const int q = nwg / NXCD, r = nwg % NXCD, xcd = wgid % NXCD, off = wgid / NXCD; wgid = (xcd < r ? xcd * (q + 1) : r * (q + 1) + (xcd - r) * q) + off; }
        const int nig = WGM * nN, gid = wgid / nig, fm = gid * WGM, gsz = (nM - fm) < WGM ? (nM - fm) : WGM;
        u.pm = fm + ((wgid % nig) % gsz); u.pn = (wgid % nig) / gsz; return true;
    }
};

template <class Epi>
__device__ __forceinline__ void gemm_phase(LAS unsigned char* lds, const Gemm g, const StaticOrder& S, const Epi& E) {
    int tid_ = threadIdx.x; asm volatile("" : "+v"(tid_));
    const int tid = tid_, wid = __builtin_amdgcn_readfirstlane(tid >> 6), lane = tid & 63, wr = wid >> 2, wc = wid & 3, fr = lane & 15, fq = lane >> 4;
    const int K = g.K, nt = K / BK;
    unsigned voffA[2], voffB[2];
#pragma unroll
    for (int i = 0; i < 2; ++i) { int R, C; stage_rc(tid * 16 + i * 8192, R, C); const int Rb = (R & ~31) + (Epi::PERMB ? perm32b(R & 31) : perm32(R & 31));
        voffA[i] = (unsigned)(R * g.lda + C) * 2u; voffB[i] = (unsigned)(Rb * g.ldb + C) * 2u; }
    const size_t kstep = (size_t)(BK * 2);
    const size_t hstepA = (size_t)HALF * g.lda * 2, hstepB = (size_t)HALF * g.ldb * 2;
    const size_t tstepA = 2 * hstepA, tstepB = 2 * hstepB;
    const unsigned ldsw = (unsigned)wid * 1024u;
    const int aoff = lds_byte(wr * 64 + fr, fq * 8), boff = lds_byte(wc * 32 + fr, fq * 8);
#define PG8_SA(b, h) (((b) * 2 + (h)) * HTB)
#define PG8_SB(b, h) ((4 + (b) * 2 + (h)) * HTB)
#define PG8_STAGE(bufoff, gbase, voff) do { _Pragma("unroll") for (int _i = 0; _i < 2; ++_i) \
        __builtin_amdgcn_global_load_lds((const unsigned*)((const char*)(gbase) + (voff)[_i]), (LAS unsigned*)(lds + (bufoff) + ldsw + _i * 8192), 16, 0, 0); } while (0)
#define PG8_LDA(dst, b, h) do { _Pragma("unroll") for (int m = 0; m < 4; ++m) _Pragma("unroll") for (int k = 0; k < 2; ++k) dst[m][k] = *(const LAS bf16x8*)(lds + PG8_SA(b, h) + aoff + m * 2048 + k * 1024); } while (0)
#define PG8_LDB(dst, b, h) do { _Pragma("unroll") for (int n = 0; n < 2; ++n) _Pragma("unroll") for (int k = 0; k < 2; ++k) dst[n][k] = *(const LAS bf16x8*)(lds + PG8_SB(b, h) + boff + n * 2048 + k * 1024); } while (0)
#define PG8_MMA(ai, bj, At, Bt) do { __builtin_amdgcn_s_setprio(1); _Pragma("unroll") for (int m = 0; m < 4; ++m) _Pragma("unroll") for (int n = 0; n < 2; ++n) _Pragma("unroll") for (int k = 0; k < 2; ++k) \
        acc[ai][bj][m][n] = __builtin_amdgcn_mfma_f32_16x16x32_bf16(Bt[n][k], At[m][k], acc[ai][bj][m][n], 0, 0, 0); __builtin_amdgcn_s_setprio(0); } while (0)
#define PG8_WAIT_V(n) asm volatile("s_waitcnt vmcnt(" #n ")" ::: "memory")
#define PG8_WAIT_L(n) asm volatile("s_waitcnt lgkmcnt(" #n ")" ::: "memory")
#define PG8_BAR __builtin_amdgcn_s_barrier()
#define PG8_SCHED __builtin_amdgcn_sched_barrier(0)
    Unit cur, nxt; int ui = 0, ubuf = 0;
    if (!S.next(0, cur)) return;
    E.prefetch(lds, cur, ubuf, wid, lane);
    f32x4 acc[2][2][4][2];
#pragma unroll
    for (int a = 0; a < 2; ++a)
#pragma unroll
        for (int b = 0; b < 2; ++b)
#pragma unroll
            for (int m = 0; m < 4; ++m)
#pragma unroll
                for (int n = 0; n < 2; ++n) acc[a][b][m][n] = (f32x4){0.f, 0.f, 0.f, 0.f};
    bf16x8 At[4][2], B0[2][2], B1[2][2];
    const char* cA = (const char*)g.A + (size_t)cur.pm * tstepA + (size_t)cur.pn * g.a_pn_off; const char* cB = (const char*)g.Bt + (size_t)cur.pn * tstepB;
    PG8_STAGE(PG8_SB(0, 0), cB, voffB); PG8_STAGE(PG8_SA(0, 0), cA, voffA); PG8_STAGE(PG8_SB(0, 1), cB + hstepB, voffB); PG8_STAGE(PG8_SA(0, 1), cA + hstepA, voffA);
    if (wr == 1) PG8_BAR;
    PG8_WAIT_V(4); PG8_BAR;
    PG8_STAGE(PG8_SB(1, 0), cB + kstep, voffB); PG8_STAGE(PG8_SA(1, 0), cA + kstep, voffA); PG8_STAGE(PG8_SB(1, 1), cB + hstepB + kstep, voffB);
    PG8_WAIT_V(6); PG8_BAR;
    for (;;) {
        const bool has_next = S.next(ui + 1, nxt);
        const char* nA = has_next ? (const char*)g.A + (size_t)nxt.pm * tstepA + (size_t)nxt.pn * g.a_pn_off : cA; const char* nB = has_next ? (const char*)g.Bt + (size_t)nxt.pn * tstepB : cB;
        for (int t = 0; t < nt; t += 2) {
            const bool last = (t == nt - 2);
            const char* a1 = cA + (size_t)(t + 1) * kstep;
            const char* a2 = last ? nA : cA + (size_t)(t + 2) * kstep; const char* b2 = last ? nB : cB + (size_t)(t + 2) * kstep;
            const char* a3 = a2 + kstep; const char* b3 = b2 + kstep;
            PG8_LDB(B0, 0, 0); PG8_SCHED; PG8_LDA(At, 0, 0); PG8_STAGE(PG8_SA(1, 1), a1 + hstepA, voffA);
            PG8_WAIT_L(8); PG8_BAR; PG8_WAIT_L(0); PG8_MMA(0, 0, At, B0); PG8_BAR; PG8_SCHED;
            PG8_LDB(B1, 0, 1); PG8_STAGE(PG8_SB(0, 0), b2, voffB);
            PG8_BAR; PG8_WAIT_L(0); PG8_MMA(0, 1, At, B1); PG8_BAR;
            PG8_LDA(At, 0, 1); PG8_STAGE(PG8_SA(0, 0), a2, voffA);
            PG8_BAR; PG8_WAIT_L(0); PG8_MMA(1, 0, At, B0); PG8_BAR; PG8_SCHED;
            PG8_STAGE(PG8_SB(0, 1), b2 + hstepB, voffB);
            PG8_WAIT_V(6); PG8_BAR; PG8_MMA(1, 1, At, B1); PG8_BAR;
            PG8_LDB(B0, 1, 0); PG8_SCHED; PG8_LDA(At, 1, 0); PG8_STAGE(PG8_SA(0, 1), a2 + hstepA, voffA);
            PG8_WAIT_L(8); PG8_BAR; PG8_WAIT_L(0); PG8_MMA(0, 0, At, B0); PG8_BAR; PG8_SCHED;
            PG8_LDB(B1, 1, 1); PG8_STAGE(PG8_SB(1, 0), b3, voffB);
            PG8_BAR; PG8_WAIT_L(0); PG8_MMA(0, 1, At, B1); PG8_BAR;
            PG8_LDA(At, 1, 1); PG8_STAGE(PG8_SA(1, 0), a3, voffA);
            PG8_BAR; PG8_WAIT_L(0); PG8_MMA(1, 0, At, B0); PG8_BAR; PG8_SCHED;
            PG8_STAGE(PG8_SB(1, 1), b3 + hstepB, voffB);
            PG8_WAIT_V(6); PG8_BAR; PG8_MMA(1, 1, At, B1); PG8_BAR;
        }
        E(acc, cur, wr, wc, fr, fq, lds, ubuf);
        if (!has_next) break;
        ubuf ^= 1; E.prefetch(lds, nxt, ubuf, wid, lane);
#pragma unroll
        for (int a = 0; a < 2; ++a)
#pragma unroll
            for (int b = 0; b < 2; ++b)
#pragma unroll
                for (int m = 0; m < 4; ++m)
#pragma unroll
                    for (int n = 0; n < 2; ++n) acc[a][b][m][n] = (f32x4){0.f, 0.f, 0.f, 0.f};
        cur = nxt; cA = nA; cB = nB; ++ui;
    }
    PG8_WAIT_V(0);
    if (wr == 0) PG8_BAR;
    PG8_BAR;
#undef PG8_SA
#undef PG8_SB
#undef PG8_STAGE
#undef PG8_LDA
#undef PG8_LDB
#undef PG8_MMA
#undef PG8_WAIT_V
#undef PG8_WAIT_L
#undef PG8_BAR
#undef PG8_SCHED
}
}
using pg8::Unit;

__device__ __forceinline__ f32x4 bf4lo(const u32x4 w) { return (f32x4){bflo(w.x), bfhi(w.x), bflo(w.y), bfhi(w.y)}; }
__device__ __forceinline__ f32x4 bf4hi(const u32x4 w) { return (f32x4){bflo(w.z), bfhi(w.z), bflo(w.w), bfhi(w.w)}; }
__device__ __forceinline__ u32x4 pack8(const f32x4 v0, const f32x4 v1) { u32x4 w; w.x = cvt_pk_bf16(v0[0], v0[1]); w.y = cvt_pk_bf16(v0[2], v0[3]); w.z = cvt_pk_bf16(v1[0], v1[1]); w.w = cvt_pk_bf16(v1[2], v1[3]); return w; }
__device__ __forceinline__ float sq8(const f32x4 v0, const f32x4 v1) { return v0[0] * v0[0] + v0[1] * v0[1] + v0[2] * v0[2] + v0[3] * v0[3] + v1[0] * v1[0] + v1[1] * v1[1] + v1[2] * v1[2] + v1[3] * v1[3]; }
struct EpiScaleBf16 {
    bf16_t* O; int ldc; const float* ss; const float* cscale;
    static constexpr bool PERMB = false;
    __device__ __forceinline__ void prefetch(LAS unsigned char*, const Unit&, int, int, int) const {}
    __device__ __forceinline__ void operator()(const f32x4 (&acc)[2][2][4][2], const Unit& u, int wr, int wc, int fr, int fq, LAS unsigned char* lds, int ubuf) const {
        const int row0 = u.pm * 256 + wr * 64 + fr, col0 = u.pn * 256 + wc * 32 + 8 * fq;
        f32x4 cs[2][2]; float rsv[2][4];
#pragma unroll
        for (int bj = 0; bj < 2; ++bj)
#pragma unroll
            for (int n = 0; n < 2; ++n) cs[bj][n] = cscale ? *(const f32x4*)(cscale + col0 + bj * 128 + 4 * n) : (f32x4){1.f, 1.f, 1.f, 1.f};
#pragma unroll
        for (int ai = 0; ai < 2; ++ai)
#pragma unroll
            for (int m = 0; m < 4; ++m) rsv[ai][m] = ss ? ss[row0 + ai * 128 + m * 16] : 0.f;
        __builtin_amdgcn_sched_barrier(0);
#pragma unroll
        for (int ai = 0; ai < 2; ++ai)
#pragma unroll
            for (int m = 0; m < 4; ++m) {
                const int row = row0 + ai * 128 + m * 16;
                const float rs = ss ? rsqrtf(rsv[ai][m] * (1.0f / 2048.0f) + NORM_EPS) : 1.0f;
                bf16_t* rowp = O + (size_t)row * ldc + col0;
#pragma unroll
                for (int bj = 0; bj < 2; ++bj) *(u32x4*)(rowp + bj * 128) = pack8(acc[ai][bj][m][0] * rs * cs[bj][0], acc[ai][bj][m][1] * rs * cs[bj][1]);
            }
    }
};
template <bool RF32> struct EpiRes {
    const void* res; bf16_t* ob; float* ssq;
    static constexpr bool PERMB = false;
    __device__ __forceinline__ void prefetch(LAS unsigned char*, const Unit&, int, int, int) const {}
    __device__ __forceinline__ void operator()(const f32x4 (&acc)[2][2][4][2], const Unit& u, int wr, int wc, int fr, int fq, LAS unsigned char* lds, int ubuf) const {
        const int row0 = u.pm * 256 + wr * 64 + fr, col0 = u.pn * 256 + wc * 32 + 8 * fq;
        if constexpr (RF32) {
#pragma unroll
            for (int ai = 0; ai < 2; ++ai) {
                f32x4 r0[4][2], r1[4][2];
#pragma unroll
                for (int m = 0; m < 4; ++m)
#pragma unroll
                    for (int bj = 0; bj < 2; ++bj) {
                        const size_t o = (size_t)(row0 + ai * 128 + m * 16) * DM + col0 + bj * 128;
                        r0[m][bj] = *(const f32x4*)((const float*)res + o); r1[m][bj] = *(const f32x4*)((const float*)res + o + 4);
                    }
                __builtin_amdgcn_sched_barrier(0);
#pragma unroll
                for (int m = 0; m < 4; ++m) {
                    const int row = row0 + ai * 128 + m * 16;
                    float s = 0.f;
#pragma unroll
                    for (int bj = 0; bj < 2; ++bj) {
                        const size_t o = (size_t)row * DM + col0 + bj * 128;
                        const f32x4 v0 = acc[ai][bj][m][0] + r0[m][bj], v1 = acc[ai][bj][m][1] + r1[m][bj];
                        *(u32x4*)(ob + o) = pack8(v0, v1);
                        s += sq8(v0, v1);
                    }
                    s += __shfl_xor(s, 16); s += __shfl_xor(s, 32);
                    if (fq == 0) unsafeAtomicAdd(ssq + row, s);
                }
            }
        } else {
            u32x4 pw[2][4][2];
#pragma unroll
            for (int ai = 0; ai < 2; ++ai)
#pragma unroll
                for (int m = 0; m < 4; ++m)
#pragma unroll
                    for (int bj = 0; bj < 2; ++bj) pw[ai][m][bj] = *(const u32x4*)((const bf16_t*)res + (size_t)(row0 + ai * 128 + m * 16) * DM + col0 + bj * 128);
            __builtin_amdgcn_sched_barrier(0);
#pragma unroll
            for (int ai = 0; ai < 2; ++ai)
#pragma unroll
                for (int m = 0; m < 4; ++m) {
                    const int row = row0 + ai * 128 + m * 16;
                    float s = 0.f;
#pragma unroll
                    for (int bj = 0; bj < 2; ++bj) {
                        const size_t o = (size_t)row * DM + col0 + bj * 128;
                        const f32x4 v0 = acc[ai][bj][m][0] + bf4lo(pw[ai][m][bj]), v1 = acc[ai][bj][m][1] + bf4hi(pw[ai][m][bj]);
                        *(u32x4*)(ob + o) = pack8(v0, v1);
                        s += sq8(v0, v1);
                    }
                    s += __shfl_xor(s, 16); s += __shfl_xor(s, 32);
                    if (fq == 0) unsafeAtomicAdd(ssq + row, s);
                }
        }
    }
};
struct EpiGate {
    const bf16_t* h2b; bf16_t* h3b; const bf16_t* proj; const float* ss3; float* ss4;
    static constexpr bool PERMB = false;
    __device__ __forceinline__ void prefetch(LAS unsigned char*, const Unit&, int, int, int) const {}
    __device__ __forceinline__ void operator()(const f32x4 (&acc)[2][2][4][2], const Unit& u, int wr, int wc, int fr, int fq, LAS unsigned char* lds, int ubuf) const {
        const int row0 = u.pm * 256 + wr * 64 + fr, col0 = u.pn * 256 + wc * 32 + 8 * fq;
#pragma unroll
        for (int ai = 0; ai < 2; ++ai) {
            u32x4 hw[4][2], pw[4][2]; float rsv[4];
#pragma unroll
            for (int m = 0; m < 4; ++m) {
                rsv[m] = ss3[row0 + ai * 128 + m * 16];
#pragma unroll
                for (int bj = 0; bj < 2; ++bj) {
                    const size_t o = (size_t)(row0 + ai * 128 + m * 16) * DM + col0 + bj * 128;
                    hw[m][bj] = *(const u32x4*)(h2b + o); pw[m][bj] = *(const u32x4*)(proj + o);
                }
            }
            __builtin_amdgcn_sched_barrier(0);
#pragma unroll
            for (int m = 0; m < 4; ++m) {
                const int row = row0 + ai * 128 + m * 16;
                const float rs = rsqrtf(rsv[m] * (1.0f / 2048.0f) + NORM_EPS);
                float s = 0.f;
#pragma unroll
                for (int bj = 0; bj < 2; ++bj) {
                    const size_t o = (size_t)row * DM + col0 + bj * 128;
                    const f32x4 r0 = bf4lo(hw[m][bj]), r1 = bf4hi(hw[m][bj]), p0 = bf4lo(pw[m][bj]), p1 = bf4hi(pw[m][bj]);
                    f32x4 v0, v1;
#pragma unroll
                    for (int j = 0; j < 4; ++j) { v0[j] = r0[j] + sigmoidf_(acc[ai][bj][m][0][j] * rs) * p0[j]; v1[j] = r1[j] + sigmoidf_(acc[ai][bj][m][1][j] * rs) * p1[j]; }
                    *(u32x4*)(h3b + o) = pack8(v0, v1);
                    s += sq8(v0, v1);
                }
                s += __shfl_xor(s, 16); s += __shfl_xor(s, 32);
                if (fq == 0) unsafeAtomicAdd(ss4 + row, s);
            }
        }
    }
};
struct EpiUp {
    static constexpr bool PERMB = true;
    bf16_t* act; float* edge; const float* ss2; const float* conv_w; const float* conv_b;
    __device__ __forceinline__ void prefetch(LAS unsigned char* lds, const Unit& u, int ubuf, int wid, int lane) const {
        if (wid < 5) {
            const int p = wid * 64 + lane, a = p >> 5, wi = p & 31;
            const float* src;
            if (a < 8) { const int par = a & 3, f = (a >> 2) * DFF + u.pn * 128 + 4 * wi; src = (par < 3) ? conv_w + par * UPC + f : conv_b + f; }
            else src = ss2 + u.pm * 256 + (p - 256) * 4;
            __builtin_amdgcn_global_load_lds((const unsigned*)src, (LAS unsigned*)(lds + EPI_LDS + ubuf * 8192 + wid * 1024), 16, 0, 0);
        }
    }
    __device__ __forceinline__ void operator()(const f32x4 (&acc)[2][2][4][2], const Unit& u, int wr, int wc, int fr, int fq, LAS unsigned char* lds, int ubuf) const {
        const LAS float* pp = (const LAS float*)(lds + EPI_LDS + ubuf * 8192);
        float rsv[2][4];
#pragma unroll
        for (int ai = 0; ai < 2; ++ai)
#pragma unroll
            for (int m = 0; m < 4; ++m) rsv[ai][m] = rsqrtf(pp[1024 + ai * 128 + wr * 64 + m * 16 + fr] * (1.0f / 2048.0f) + NORM_EPS);
#pragma unroll
        for (int n = 0; n < 2; ++n) {
            const int cf = wc * 32 + 16 * n + 8 * (fq & 1) + 4 * (fq >> 1);
            const int f = u.pn * 128 + cf;
            const f32x4 w0g = *(const LAS f32x4*)(pp + cf), w1g = *(const LAS f32x4*)(pp + 128 + cf), w2g = *(const LAS f32x4*)(pp + 256 + cf), bg = *(const LAS f32x4*)(pp + 384 + cf);
            const f32x4 w0v = *(const LAS f32x4*)(pp + 512 + cf), w1v = *(const LAS f32x4*)(pp + 640 + cf), w2v = *(const LAS f32x4*)(pp + 768 + cf), bv = *(const LAS f32x4*)(pp + 896 + cf);
#pragma unroll
            for (int ai = 0; ai < 2; ++ai) {
                const int run = u.pm * 4 + ai * 2 + wr;
                float* eg = edge + (size_t)run * 4 * UPC + u.pn * 256 + cf;
                f32x4 pG = {0.f, 0.f, 0.f, 0.f}, pV = {0.f, 0.f, 0.f, 0.f}; u32x2 wprev = {0u, 0u};
#pragma unroll
                for (int m = 0; m < 4; ++m) {
                    const int row = run * 64 + m * 16 + fr;
                    const float rs = rsv[ai][m];
                    const f32x4 G = acc[ai][0][m][n] * rs, V = acc[ai][1][m][n] * rs;
                    if (m == 0 && fr < 2) { *(f32x4*)(eg + (size_t)fr * UPC) = G; *(f32x4*)(eg + (size_t)fr * UPC + 128) = V; }
                    if (m == 3 && fr >= 14) { *(f32x4*)(eg + (size_t)(fr - 12) * UPC) = G; *(f32x4*)(eg + (size_t)(fr - 12) * UPC + 128) = V; }
                    f32x4 g1, g2, v1, v2;
#pragma unroll
                    for (int j = 0; j < 4; ++j) {
                        g1[j] = dpp_f<0x111>(G[j]) + dpp_f<0x10F>(pG[j]); g2[j] = dpp_f<0x112>(G[j]) + dpp_f<0x10E>(pG[j]);
                        v1[j] = dpp_f<0x111>(V[j]) + dpp_f<0x10F>(pV[j]); v2[j] = dpp_f<0x112>(V[j]) + dpp_f<0x10E>(pV[j]);
                    }
                    const f32x4 gate = bg + w2g * G + w1g * g1 + w0g * g2;
                    const f32x4 val = bv + w2v * V + w1v * v1 + w0v * v2;
                    f32x4 a;
#pragma unroll
                    for (int j = 0; j < 4; ++j) a[j] = gate[j] * sigmoidf_(gate[j]) * val[j];
                    u32x2 w; w.x = cvt_pk_bf16(a[0], a[1]); w.y = cvt_pk_bf16(a[2], a[3]);
                    if ((m & 1) == 0) wprev = w;
                    else {
                        const auto rx = __builtin_amdgcn_permlane32_swap(wprev.x, w.x, false, false);
                        const auto ry = __builtin_amdgcn_permlane32_swap(wprev.y, w.y, false, false);
                        u32x4 o; o.x = rx[0]; o.y = ry[0]; o.z = rx[1]; o.w = ry[1];
                        const int srow = row - 16 + 16 * (fq >> 1);
                        *(u32x4*)(act + (size_t)srow * DFF + f - 4 * (fq >> 1)) = o;
                    }
                    pG = G; pV = V;
                }
            }
        }
    }
};

struct WtJob { const float* W; const float* scale; bf16_t* Bt; int ldw, ldb, k0, n0, up; };
__device__ __forceinline__ bool wt_job(const Params& P, int id, WtJob& j) {
    unsigned char* ws = P.ws;
    const int T0 = 640, T1 = T0 + 1376, T2 = T1 + 688, T3 = T2 + 256, T4 = T3 + 256, T5 = T4 + 32, T6 = T5 + 16;
    if (id >= T6) return false;
    j.up = 0;
    if (id < T0) { const int nt = id % 20, kt = id / 20; j = WtJob{P.w_in, P.norm1_w, (bf16_t*)(ws + OFF_WIN), INC, DM, kt * 64, nt * 256, 0}; }
    else if (id < T1) { const int l = id - T0, nt = l % 43, kt = l / 43; j = WtJob{P.w_up, P.norm2_w, (bf16_t*)(ws + OFF_WUP), UPC, DM, kt * 64, nt * 256, 1}; }
    else if (id < T2) { const int l = id - T1, nt = l % 8, kt = l / 8; j = WtJob{P.w_down, nullptr, (bf16_t*)(ws + OFF_WDOWN), DM, DFF, kt * 64, nt * 256, 0}; }
    else if (id < T3) { const int l = id - T2, nt = l % 8, kt = l / 8; j = WtJob{P.w_out, nullptr, (bf16_t*)(ws + OFF_WOUT), DM, DM, kt * 64, nt * 256, 0}; }
    else if (id < T4) { const int l = id - T3, nt = l % 8, kt = l / 8; j = WtJob{P.ple_gate_w, P.norm3_w, (bf16_t*)(ws + OFF_WGATE), DM, DM, kt * 64, nt * 256, 0}; }
    else if (id < T5) { const int l = id - T4, nt = l % 8, kt = l / 8; j = WtJob{P.ple_proj_w, nullptr, (bf16_t*)(ws + OFF_WPROJ), DM, PLE, kt * 64, nt * 256, 0}; }
    else { const int l = id - T5, g = l >> 2, kt = l & 3; j = WtJob{P.pool_w + g * 65536, nullptr, (bf16_t*)(ws + OFF_POOLT) + g * 65536, 256, 256, kt * 64, 0, 0}; }
    return true;
}
__device__ __forceinline__ void wt_load(const WtJob& j, f32x4 (&v)[8]) {
    const int c4 = (threadIdx.x & 63) * 4, r = threadIdx.x >> 6;
#pragma unroll
    for (int i = 0; i < 8; ++i) v[i] = *(const f32x4*)(j.W + (size_t)(j.k0 + r + 8 * i) * j.ldw + j.n0 + c4);
}
__device__ __forceinline__ void wt_put(const WtJob& j, const f32x4 (&v)[8], float* tile) {
    const int c4 = (threadIdx.x & 63) * 4, r = threadIdx.x >> 6;
#pragma unroll
    for (int i = 0; i < 8; ++i) { const int k = r + 8 * i; const float sc = j.scale ? j.scale[j.k0 + k] : 1.0f; *(f32x4*)(tile + k * 260 + (c4 ^ (4 * i))) = v[i] * sc; }
}
__device__ __forceinline__ void wt_store(const WtJob& j, const float* tile) {
#pragma unroll
    for (int it = 0; it < 4; ++it) {
        const int item = threadIdx.x + 512 * it, n = item >> 3, ko = item & 7; float v[8];
#pragma unroll
        for (int i = 0; i < 8; ++i) v[i] = tile[(ko * 8 + i) * 260 + (n ^ (4 * ko))];
        int nn = j.n0 + n;
        if (j.up) { const int half = nn >= DFF ? 1 : 0, f = nn - half * DFF; nn = 256 * (f >> 7) + 128 * half + (f & 127); }
        u32x4 w; w.x = cvt_pk_bf16(v[0], v[1]); w.y = cvt_pk_bf16(v[2], v[3]); w.z = cvt_pk_bf16(v[4], v[5]); w.w = cvt_pk_bf16(v[6], v[7]);
        *(u32x4*)(j.Bt + (size_t)nn * j.ldb + j.k0 + ko * 8) = w;
    }
}

__device__ void wt_convert(const Params& P, unsigned char* shm, int lo, int hi) {
    float* tile = (float*)shm; WtJob cur, nxt; f32x4 v[8];
    int id = lo + blockIdx.x; bool have = id < hi && wt_job(P, id, cur);
    if (have) wt_load(cur, v);
    while (have) {
        wt_put(cur, v, tile);
        __syncthreads();
        id += gridDim.x; const bool hn = id < hi && wt_job(P, id, nxt);
        if (hn) wt_load(nxt, v);
        wt_store(cur, tile);
        __syncthreads();
        cur = nxt; have = hn;
    }
}
__device__ void ph_prologue(const Params& P, unsigned char* shm) {
    const int tid = threadIdx.x, lane = tid & 63, wid = tid >> 6;
    const int gw = blockIdx.x * 8 + wid, nw = gridDim.x * 8;
    const int gt = blockIdx.x * 512 + tid, ntot = gridDim.x * 512;
    unsigned char* ws = P.ws;
    { bf16_t* xb = (bf16_t*)(ws + OFF_XB); float* ss1 = (float*)(ws + OFF_SUMSQ);
      for (int row = gw; row < NTOK; row += nw) {
          const f32x4* src = (const f32x4*)(P.x + (size_t)row * DM); u32x2* dst = (u32x2*)(xb + (size_t)row * DM); float s = 0.f;
#pragma unroll
          for (int i = 0; i < 8; ++i) { const f32x4 v = src[i * 64 + lane]; s += v[0] * v[0] + v[1] * v[1] + v[2] * v[2] + v[3] * v[3];
              u32x2 w; w.x = cvt_pk_bf16(v[0], v[1]); w.y = cvt_pk_bf16(v[2], v[3]); dst[i * 64 + lane] = w; }
          s = wave_sum(s); if (lane == 0) ss1[row] = s; } }
    { const f32x4* src = (const f32x4*)P.p; u32x2* dst = (u32x2*)(ws + OFF_PB);
      for (int i = gt; i < NTOK * PLE / 4; i += ntot) { const f32x4 v = src[i]; u32x2 w; w.x = cvt_pk_bf16(v[0], v[1]); w.y = cvt_pk_bf16(v[2], v[3]); dst[i] = w; } }
    { float* ss = (float*)(ws + OFF_SUMSQ) + NTOK; for (int i = gt; i < 3 * NTOK; i += ntot) ss[i] = 0.f; }
    { float* ct = (float*)(ws + OFF_COS); float* st = (float*)(ws + OFF_SIN);
      for (int i = gt; i < SEQ * 64; i += ntot) { const int pos = i >> 6, fi = i & 63; const float ang = (float)pos * P.inv_freq[fi];
          double rev = (double)ang * 0.15915494309189533577; rev -= rint(rev); const float rv = (float)rev;
          ct[i] = __builtin_amdgcn_cosf(rv); st[i] = __builtin_amdgcn_sinf(rv); } }
    wt_convert(P, shm, 0, 640);
    wt_convert(P, shm, 3248, 3264);
}

__device__ __forceinline__ void bf8_acc(float (&s)[8], const u32x4 v, float sg) {
    s[0] += sg * bflo(v.x); s[1] += sg * bfhi(v.x); s[2] += sg * bflo(v.y); s[3] += sg * bfhi(v.y); s[4] += sg * bflo(v.z); s[5] += sg * bfhi(v.z); s[6] += sg * bflo(v.w); s[7] += sg * bfhi(v.w);
}
__device__ void ph_pool_diff(const Params& P) {
    const bf16_t* __restrict__ z = (const bf16_t*)(P.ws + OFF_Z); bf16_t* __restrict__ diff = (bf16_t*)(P.ws + OFF_DIFF);
    for (int it = blockIdx.x * 512 + threadIdx.x; it < 1024 * 128; it += gridDim.x * 512) {
        const int strip = it >> 7, oc = it & 127; const int R0 = strip * 16, s0 = R0 & (SEQ - 1); const int w = 2 << (oc >> 5);
        const bf16_t* zc = z + 8 * oc;
        float s[8];
#pragma unroll
        for (int i = 0; i < 8; ++i) s[i] = 0.f;
        if (s0 > 0) {
            u32x4 pv[16];
#pragma unroll
            for (int d = 1; d <= 16; ++d) pv[d - 1] = (d <= w) ? *(const u32x4*)(zc + (size_t)(R0 - d) * INC) : (u32x4){0u, 0u, 0u, 0u};
#pragma unroll
            for (int d = 1; d <= 16; ++d) bf8_acc(s, pv[d - 1], 1.0f);
        }
#pragma unroll
        for (int half = 0; half < 2; ++half) {
            u32x4 cu[8], od[8];
#pragma unroll
            for (int r = 0; r < 8; ++r) { const int rr = half * 8 + r; cu[r] = *(const u32x4*)(zc + (size_t)(R0 + rr) * INC);
                od[r] = (s0 + rr - w >= 0) ? *(const u32x4*)(zc + (size_t)(R0 + rr - w) * INC) : (u32x4){0u, 0u, 0u, 0u}; }
#pragma unroll
            for (int r = 0; r < 8; ++r) {
                const int rr = half * 8 + r, t = s0 + rr;
                bf8_acc(s, cu[r], 1.0f); bf8_acc(s, od[r], -1.0f);
                const float inv = 1.0f / (float)(t + 1 < w ? t + 1 : w);
                const u32x4 v = cu[r];
                u32x4 ow; ow.x = cvt_pk_bf16(s[0] * inv - bflo(v.x), s[1] * inv - bfhi(v.x)); ow.y = cvt_pk_bf16(s[2] * inv - bflo(v.y), s[3] * inv - bfhi(v.y));
                ow.z = cvt_pk_bf16(s[4] * inv - bflo(v.z), s[5] * inv - bfhi(v.z)); ow.w = cvt_pk_bf16(s[6] * inv - bflo(v.w), s[7] * inv - bfhi(v.w));
                *(u32x4*)(diff + (size_t)(R0 + rr) * 1024 + 8 * oc) = ow;
            }
        }
    }
}

constexpr int LP = 136;
struct KRaw { u32x4 a, c; f32x4 c0, c1, s0, s1; };
__device__ __forceinline__ void k_load(const bf16_t* z, const float* cosT, const float* sinT, int b, int h, int n, int it, KRaw& r) {
    const int j = it >> 3, o = it & 7, pos = n * 128 + j; const size_t t = (size_t)b * SEQ + pos;
    const bf16_t* kp = z + t * INC + 2048 + h * 128 + 8 * o;
    r.a = *(const u32x4*)kp; r.c = *(const u32x4*)(kp + 64);
    r.c0 = *(const f32x4*)(cosT + pos * 64 + 8 * o); r.c1 = *(const f32x4*)(cosT + pos * 64 + 8 * o + 4);
    r.s0 = *(const f32x4*)(sinT + pos * 64 + 8 * o); r.s1 = *(const f32x4*)(sinT + pos * 64 + 8 * o + 4);
}
template <bool TR> __device__ __forceinline__ void k_put(const KRaw& r, int it, float log2g, bf16_t* dst) {
    const int j = it >> 3, o = it & 7;
    const float sc = 0.08838834764831845f * (TR ? exp2f((float)(127 - j) * log2g) : 1.0f);
    const float x1[8] = {bflo(r.a.x), bfhi(r.a.x), bflo(r.a.y), bfhi(r.a.y), bflo(r.a.z), bfhi(r.a.z), bflo(r.a.w), bfhi(r.a.w)};
    const float x2[8] = {bflo(r.c.x), bfhi(r.c.x), bflo(r.c.y), bfhi(r.c.y), bflo(r.c.z), bfhi(r.c.z), bflo(r.c.w), bfhi(r.c.w)};
    const float cc[8] = {r.c0[0], r.c0[1], r.c0[2], r.c0[3], r.c1[0], r.c1[1], r.c1[2], r.c1[3]}, ss[8] = {r.s0[0], r.s0[1], r.s0[2], r.s0[3], r.s1[0], r.s1[1], r.s1[2], r.s1[3]};
    float o1[8], o2[8];
#pragma unroll
    for (int i = 0; i < 8; ++i) { o1[i] = (x1[i] * cc[i] - x2[i] * ss[i]) * sc; o2[i] = (x2[i] * cc[i] + x1[i] * ss[i]) * sc; }
    if (TR) {
#pragma unroll
        for (int i = 0; i < 8; ++i) { const unsigned pk = cvt_pk_bf16(o1[i], o2[i]); dst[(8 * o + i) * LP + j] = (bf16_t)(pk & 0xffffu); dst[(64 + 8 * o + i) * LP + j] = (bf16_t)(pk >> 16); }
    } else {
        u32x4 w1, w2; w1.x = cvt_pk_bf16(o1[0], o1[1]); w1.y = cvt_pk_bf16(o1[2], o1[3]); w1.z = cvt_pk_bf16(o1[4], o1[5]); w1.w = cvt_pk_bf16(o1[6], o1[7]);
        w2.x = cvt_pk_bf16(o2[0], o2[1]); w2.y = cvt_pk_bf16(o2[2], o2[3]); w2.z = cvt_pk_bf16(o2[4], o2[5]); w2.w = cvt_pk_bf16(o2[6], o2[7]);
        *(u32x4*)(dst + j * LP + 8 * o) = w1; *(u32x4*)(dst + j * LP + 64 + 8 * o) = w2;
    }
}
__device__ __forceinline__ u32x4 v_load(const bf16_t* z, int b, int h, int n, int it) {
    const int j = it >> 4, o = it & 15; const size_t t = (size_t)b * SEQ + n * 128 + j;
    return *(const u32x4*)(z + t * INC + 3072 + h * 128 + 8 * o);
}
__device__ __forceinline__ void v_put(const u32x4 v, int it, bf16_t* dst) {
    const int j = it >> 4, o = it & 15; const unsigned w[4] = {v.x, v.y, v.z, v.w};
#pragma unroll
    for (int i = 0; i < 4; ++i) { dst[(8 * o + 2 * i) * LP + j] = (bf16_t)(w[i] & 0xffffu); dst[(8 * o + 2 * i + 1) * LP + j] = (bf16_t)(w[i] >> 16); }
}

__device__ void ph_ret_kv(const Params& P, unsigned char* shm) {
    const bf16_t* z = (const bf16_t*)(P.ws + OFF_Z); const float* cosT = (const float*)(P.ws + OFF_COS); const float* sinT = (const float*)(P.ws + OFF_SIN);
    bf16_t* kvT = (bf16_t*)(P.ws + OFF_KVT);
    bf16_t* kT = (bf16_t*)shm; bf16_t* vT = kT + 128 * LP;
    const int tid = threadIdx.x, w = __builtin_amdgcn_readfirstlane(tid >> 6), lane = tid & 63, fr = lane & 15, fq = lane >> 4;
    for (int ui = blockIdx.x; ui < 960; ui += gridDim.x) {
        const int bh = ui / 15, n = ui - bh * 15, h = bh & 7, b = bh >> 3, unit = bh * 16 + n;
        KRaw kr[2]; u32x4 vr[4];
#pragma unroll
        for (int i = 0; i < 4; ++i) vr[i] = v_load(z, b, h, n, tid + 512 * i);
#pragma unroll
        for (int i = 0; i < 2; ++i) k_load(z, cosT, sinT, b, h, n, tid + 512 * i, kr[i]);
#pragma unroll
        for (int i = 0; i < 4; ++i) v_put(vr[i], tid + 512 * i, vT);
#pragma unroll
        for (int i = 0; i < 2; ++i) k_put<true>(kr[i], tid + 512 * i, P.log2g[h], kT);
        __syncthreads();
        f32x4 acc[8];
#pragma unroll
        for (int eb = 0; eb < 8; ++eb) acc[eb] = (f32x4){0.f, 0.f, 0.f, 0.f};
#pragma unroll
        for (int ks = 0; ks < 4; ++ks) {
            const bf16x8 a = *(const bf16x8*)(kT + (16 * w + fr) * LP + 32 * ks + 8 * fq);
#pragma unroll
            for (int eb = 0; eb < 8; ++eb) { const bf16x8 bb = *(const bf16x8*)(vT + (16 * eb + fr) * LP + 32 * ks + 8 * fq); acc[eb] = __builtin_amdgcn_mfma_f32_16x16x32_bf16(a, bb, acc[eb], 0, 0, 0); }
        }
        bf16_t* dst = kvT + (size_t)unit * 16384;
#pragma unroll
        for (int eb = 0; eb < 8; ++eb) { u32x2 kw; kw.x = cvt_pk_bf16(acc[eb][0], acc[eb][1]); kw.y = cvt_pk_bf16(acc[eb][2], acc[eb][3]); *(u32x2*)(dst + (16 * eb + fr) * 128 + 16 * w + 4 * fq) = kw; }
        __syncthreads();
    }
}
__device__ void ph_ret_scan(const Params& P) {
    const bf16_t* kvT = (const bf16_t*)(P.ws + OFF_KVT); bf16_t* RT = (bf16_t*)(P.ws + OFF_RT);
    for (int it = blockIdx.x * 512 + threadIdx.x; it < 64 * 4096; it += gridDim.x * 512) {
        const int bh = it >> 12, q4 = it & 4095; const float gc = exp2f(128.0f * P.log2g[bh & 7]);
        const size_t o0 = ((size_t)(bh * 16)) * 16384 + 4 * q4;
        u32x2 kv[15];
#pragma unroll
        for (int n = 0; n < 15; ++n) kv[n] = *(const u32x2*)(kvT + o0 + (size_t)n * 16384);
        f32x4 R = {0.f, 0.f, 0.f, 0.f};
#pragma unroll
        for (int n = 0; n < 16; ++n) {
            u32x2 w; w.x = cvt_pk_bf16(R[0], R[1]); w.y = cvt_pk_bf16(R[2], R[3]); *(u32x2*)(RT + o0 + (size_t)n * 16384) = w;
            if (n < 15) R = R * gc + (f32x4){bflo(kv[n].x), bfhi(kv[n].x), bflo(kv[n].y), bfhi(kv[n].y)};
        }
    }
}
__device__ void ph_ret_out(const Params& P, unsigned char* shm) {
    const bf16_t* z = (const bf16_t*)(P.ws + OFF_Z); const float* cosT = (const float*)(P.ws + OFF_COS); const float* sinT = (const float*)(P.ws + OFF_SIN);
    const bf16_t* RT = (const bf16_t*)(P.ws + OFF_RT); bf16_t* mix = (bf16_t*)(P.ws + OFF_MIX);
    bf16_t* kn = (bf16_t*)shm; bf16_t* vT = kn + 128 * LP; bf16_t* rts = vT + 128 * LP;
    const int tid = threadIdx.x, w = __builtin_amdgcn_readfirstlane(tid >> 6), lane = tid & 63, fr = lane & 15, fq = lane >> 4;
    for (int unit = blockIdx.x; unit < 1024; unit += gridDim.x) {
        const int n = unit & 15, h = (unit >> 4) & 7, b = unit >> 7; const float log2g = P.log2g[h];
        const int il = 16 * w + fr, pos = n * 128 + il; const size_t t = (size_t)b * SEQ + pos;
        KRaw kr[2]; u32x4 vr[4], rr[4]; KRaw qr[2]; u32x2 gg[8];
#pragma unroll
        for (int i = 0; i < 4; ++i) vr[i] = v_load(z, b, h, n, tid + 512 * i);
#pragma unroll
        for (int i = 0; i < 2; ++i) k_load(z, cosT, sinT, b, h, n, tid + 512 * i, kr[i]);
        if (n > 0) {
#pragma unroll
            for (int i = 0; i < 4; ++i) { const int it = tid + 512 * i; rr[i] = *(const u32x4*)(RT + (size_t)unit * 16384 + (it >> 4) * 128 + (it & 15) * 8); }
        }
#pragma unroll
        for (int kp = 0; kp < 2; ++kp) {
            const int d0 = 8 * fq + 32 * kp; const bf16_t* qp = z + t * INC + 1024 + h * 128 + d0;
            qr[kp].a = *(const u32x4*)qp; qr[kp].c = *(const u32x4*)(qp + 64);
            qr[kp].c0 = *(const f32x4*)(cosT + pos * 64 + d0); qr[kp].c1 = *(const f32x4*)(cosT + pos * 64 + d0 + 4);
            qr[kp].s0 = *(const f32x4*)(sinT + pos * 64 + d0); qr[kp].s1 = *(const f32x4*)(sinT + pos * 64 + d0 + 4);
        }
#pragma unroll
        for (int eb = 0; eb < 8; ++eb) gg[eb] = *(const u32x2*)(z + t * INC + 4096 + h * 128 + 16 * eb + 4 * fq);
        __builtin_amdgcn_sched_barrier(0);
#pragma unroll
        for (int i = 0; i < 4; ++i) v_put(vr[i], tid + 512 * i, vT);
#pragma unroll
        for (int i = 0; i < 2; ++i) k_put<false>(kr[i], tid + 512 * i, log2g, kn);
        if (n > 0) {
#pragma unroll
            for (int i = 0; i < 4; ++i) { const int it = tid + 512 * i; *(u32x4*)(rts + (it >> 4) * LP + (it & 15) * 8) = rr[i]; }
        }
        bf16x8 qf[4];
#pragma unroll
        for (int kp = 0; kp < 2; ++kp) {
            const u32x4 a = qr[kp].a, c = qr[kp].c;
            const float x1[8] = {bflo(a.x), bfhi(a.x), bflo(a.y), bfhi(a.y), bflo(a.z), bfhi(a.z), bflo(a.w), bfhi(a.w)};
            const float x2[8] = {bflo(c.x), bfhi(c.x), bflo(c.y), bfhi(c.y), bflo(c.z), bfhi(c.z), bflo(c.w), bfhi(c.w)};
            const float cc[8] = {qr[kp].c0[0], qr[kp].c0[1], qr[kp].c0[2], qr[kp].c0[3], qr[kp].c1[0], qr[kp].c1[1], qr[kp].c1[2], qr[kp].c1[3]};
            const float ss[8] = {qr[kp].s0[0], qr[kp].s0[1], qr[kp].s0[2], qr[kp].s0[3], qr[kp].s1[0], qr[kp].s1[1], qr[kp].s1[2], qr[kp].s1[3]};
            float o1[8], o2[8];
#pragma unroll
            for (int i = 0; i < 8; ++i) { o1[i] = x1[i] * cc[i] - x2[i] * ss[i]; o2[i] = x2[i] * cc[i] + x1[i] * ss[i]; }
            u32x4 w1, w2; w1.x = cvt_pk_bf16(o1[0], o1[1]); w1.y = cvt_pk_bf16(o1[2], o1[3]); w1.z = cvt_pk_bf16(o1[4], o1[5]); w1.w = cvt_pk_bf16(o1[6], o1[7]);
            w2.x = cvt_pk_bf16(o2[0], o2[1]); w2.y = cvt_pk_bf16(o2[2], o2[3]); w2.z = cvt_pk_bf16(o2[4], o2[5]); w2.w = cvt_pk_bf16(o2[6], o2[7]);
            qf[kp] = __builtin_bit_cast(bf16x8, w1); qf[kp + 2] = __builtin_bit_cast(bf16x8, w2);
        }
        __syncthreads();
        f32x4 acc[8];
#pragma unroll
        for (int eb = 0; eb < 8; ++eb) acc[eb] = (f32x4){0.f, 0.f, 0.f, 0.f};
        if (n > 0) {
#pragma unroll
            for (int ks = 0; ks < 4; ++ks)
#pragma unroll
                for (int eb = 0; eb < 8; ++eb) { const bf16x8 a = *(const bf16x8*)(rts + (16 * eb + fr) * LP + 32 * ks + 8 * fq); acc[eb] = __builtin_amdgcn_mfma_f32_16x16x32_bf16(a, qf[ks], acc[eb], 0, 0, 0); }
            const float xi = exp2f((float)(il + 1) * log2g);
#pragma unroll
            for (int eb = 0; eb < 8; ++eb) acc[eb] *= xi;
        }
        for (int s = 0; s <= (w >> 1); ++s) {
            const int jb0 = 2 * s, jb1 = 2 * s + 1;
            f32x4 st0 = {0.f, 0.f, 0.f, 0.f}, st1 = {0.f, 0.f, 0.f, 0.f};
#pragma unroll
            for (int ks = 0; ks < 4; ++ks) { const bf16x8 a0 = *(const bf16x8*)(kn + (16 * jb0 + fr) * LP + 32 * ks + 8 * fq); st0 = __builtin_amdgcn_mfma_f32_16x16x32_bf16(a0, qf[ks], st0, 0, 0, 0); }
            if (jb1 <= w) {
#pragma unroll
                for (int ks = 0; ks < 4; ++ks) { const bf16x8 a1 = *(const bf16x8*)(kn + (16 * jb1 + fr) * LP + 32 * ks + 8 * fq); st1 = __builtin_amdgcn_mfma_f32_16x16x32_bf16(a1, qf[ks], st1, 0, 0, 0); }
            }
#pragma unroll
            for (int r = 0; r < 4; ++r) {
                const int d0 = il - (16 * jb0 + 4 * fq + r), d1 = il - (16 * jb1 + 4 * fq + r);
                st0[r] = d0 >= 0 ? st0[r] * exp2f((float)d0 * log2g) : 0.f;
                st1[r] = d1 >= 0 ? st1[r] * exp2f((float)d1 * log2g) : 0.f;
            }
            u32x4 sw; sw.x = cvt_pk_bf16(st0[0], st0[1]); sw.y = cvt_pk_bf16(st0[2], st0[3]); sw.z = cvt_pk_bf16(st1[0], st1[1]); sw.w = cvt_pk_bf16(st1[2], st1[3]);
            const bf16x8 sb = __builtin_bit_cast(bf16x8, sw);
#pragma unroll
            for (int eb = 0; eb < 8; ++eb) {
                const bf16_t* vp = vT + (16 * eb + fr) * LP + 32 * s + 4 * fq;
                const u32x2 lo = *(const u32x2*)vp, hi = *(const u32x2*)(vp + 16);
                u32x4 aw; aw.x = lo.x; aw.y = lo.y; aw.z = hi.x; aw.w = hi.y;
                acc[eb] = __builtin_amdgcn_mfma_f32_16x16x32_bf16(__builtin_bit_cast(bf16x8, aw), sb, acc[eb], 0, 0, 0);
            }
        }
        float sm = 0.f;
#pragma unroll
        for (int eb = 0; eb < 8; ++eb) sm += (acc[eb][0] + acc[eb][1]) + (acc[eb][2] + acc[eb][3]);
        sm += __shfl_xor(sm, 16); sm += __shfl_xor(sm, 32);
        const float mu = sm * (1.0f / 128.0f);
        float qv = 0.f;
#pragma unroll
        for (int eb = 0; eb < 8; ++eb) { const f32x4 d = acc[eb] - mu; qv += (d[0] * d[0] + d[1] * d[1]) + (d[2] * d[2] + d[3] * d[3]); }
        qv += __shfl_xor(qv, 16); qv += __shfl_xor(qv, 32);
        const float rstd = rsqrtf(qv * (1.0f / 128.0f) + GN_EPS);
#pragma unroll
        for (int eb = 0; eb < 8; ++eb) {
            const int e0 = 16 * eb + 4 * fq;
            const f32x4 gw = *(const f32x4*)(P.ret_gn_w + h * 128 + e0);
            const float gv[4] = {bflo(gg[eb].x), bfhi(gg[eb].x), bflo(gg[eb].y), bfhi(gg[eb].y)};
            float y[4];
#pragma unroll
            for (int r = 0; r < 4; ++r) y[r] = (acc[eb][r] - mu) * rstd * gw[r] * gv[r] * sigmoidf_(gv[r]);
            u32x2 ow; ow.x = cvt_pk_bf16(y[0], y[1]); ow.y = cvt_pk_bf16(y[2], y[3]);
            *(u32x2*)(mix + t * DM + 1024 + h * 128 + e0) = ow;
        }
        __syncthreads();
    }
}
__device__ void ph_fixup(const Params& P) {
    const float* edge = (const float*)(P.ws + OFF_EDGE); bf16_t* act = (bf16_t*)(P.ws + OFF_ACT);
    for (int it = blockIdx.x * 512 + threadIdx.x; it < 256 * 1376; it += gridDim.x * 512) {
        const int fq4 = it % 1376, run = it / 1376;
        if ((run & 31) == 0) continue;
        const int f = 4 * fq4, pn = f >> 7, cf = f & 127, cg_ = pn * 256 + cf, cv_ = cg_ + 128;
        const float* e1 = edge + (size_t)run * 4 * UPC; const float* e0 = edge + (size_t)(run - 1) * 4 * UPC;
        const f32x4 Ga = *(const f32x4*)(e0 + 2 * UPC + cg_), Gb = *(const f32x4*)(e0 + 3 * UPC + cg_), Gc = *(const f32x4*)(e1 + cg_), Gd = *(const f32x4*)(e1 + UPC + cg_);
        const f32x4 Va = *(const f32x4*)(e0 + 2 * UPC + cv_), Vb = *(const f32x4*)(e0 + 3 * UPC + cv_), Vc = *(const f32x4*)(e1 + cv_), Vd = *(const f32x4*)(e1 + UPC + cv_);
        const float* cw = P.conv_w; const float* cb = P.conv_b;
        const f32x4 w0g = *(const f32x4*)(cw + f), w1g = *(const f32x4*)(cw + UPC + f), w2g = *(const f32x4*)(cw + 2 * UPC + f), bg = *(const f32x4*)(cb + f);
        const f32x4 w0v = *(const f32x4*)(cw + DFF + f), w1v = *(const f32x4*)(cw + UPC + DFF + f), w2v = *(const f32x4*)(cw + 2 * UPC + DFF + f), bv = *(const f32x4*)(cb + DFF + f);
        const f32x4 gate0 = bg + w2g * Gc + w1g * Gb + w0g * Ga, val0 = bv + w2v * Vc + w1v * Vb + w0v * Va;
        const f32x4 gate1 = bg + w2g * Gd + w1g * Gc + w0g * Gb, val1 = bv + w2v * Vd + w1v * Vc + w0v * Vb;
        f32x4 a0, a1;
#pragma unroll
        for (int j = 0; j < 4; ++j) { a0[j] = gate0[j] * sigmoidf_(gate0[j]) * val0[j]; a1[j] = gate1[j] * sigmoidf_(gate1[j]) * val1[j]; }
        u32x2 w0, w1; w0.x = cvt_pk_bf16(a0[0], a0[1]); w0.y = cvt_pk_bf16(a0[2], a0[3]); w1.x = cvt_pk_bf16(a1[0], a1[1]); w1.y = cvt_pk_bf16(a1[2], a1[3]);
        *(u32x2*)(act + (size_t)(run * 64) * DFF + f) = w0; *(u32x2*)(act + (size_t)(run * 64 + 1) * DFF + f) = w1;
    }
}
__device__ void ph_final(const Params& P) {
    const int lane = threadIdx.x & 63, gw = blockIdx.x * 8 + (threadIdx.x >> 6), nw = gridDim.x * 8;
    const float* ss4 = (const float*)(P.ws + OFF_SUMSQ) + 3 * NTOK; const bf16_t* h3b = (const bf16_t*)(P.ws + OFF_H3B);
    for (int row = gw; row < NTOK; row += nw) {
        const float rs = rsqrtf(ss4[row] * (1.0f / 2048.0f) + NORM_EPS);
        f32x4* o = (f32x4*)(P.out + (size_t)row * DM); const f32x4* fw = (const f32x4*)P.final_norm_w; const u32x4* hi = (const u32x4*)(h3b + (size_t)row * DM);
#pragma unroll
        for (int i = 0; i < 4; ++i) { const u32x4 hw = hi[i * 64 + lane]; const int c = (i * 64 + lane) * 2;
            const f32x4 a = {bflo(hw.x), bfhi(hw.x), bflo(hw.y), bfhi(hw.y)}, b = {bflo(hw.z), bfhi(hw.z), bflo(hw.w), bfhi(hw.w)};
            o[c] = a * rs * fw[c]; o[c + 1] = b * rs * fw[c + 1]; }
    }
}

#define XB_TMO      128
#define XB_XCNT(j)  (256  + 64 * (j))
#define XB_XSUB(j)  (1280 + 64 * (j))
#define XB_XGEN(j)  (2304 + 64 * (j))
#define XB_TOP      3328
#define XB_TOPGEN   3392
#define XCD_BAR_WORDS 3456
#define XB_SPIN_CAP (1u << 18)
__device__ __forceinline__ unsigned xb_ld(unsigned* p)              { return __hip_atomic_load(p, __ATOMIC_RELAXED, __HIP_MEMORY_SCOPE_AGENT); }
__device__ __forceinline__ unsigned xb_add(unsigned* p, unsigned v) { return __hip_atomic_fetch_add(p, v, __ATOMIC_RELAXED, __HIP_MEMORY_SCOPE_AGENT); }
__device__ __forceinline__ unsigned xb_xcc_id() { return (unsigned)__builtin_amdgcn_s_getreg((3 << 11) | 20) & 0xFu; }
#define XB_SPIN(cond, bar) do { unsigned _sp = 0; while (cond) { __builtin_amdgcn_s_sleep(1); \
    if ((++_sp & 255u) == 0u) { if (xb_ld(&(bar)[XB_TMO])) break; if (_sp > XB_SPIN_CAP) { atomicAdd(&(bar)[XB_TMO], 1u); break; } } } } while (0)
struct XcdBarrier { unsigned* bar; unsigned x; volatile LAS unsigned* st; };
__device__ __forceinline__ XcdBarrier xcd_barrier_post(unsigned* bar, volatile LAS unsigned* st) {
    XcdBarrier b; b.bar = bar; b.x = xb_xcc_id(); b.st = st;
    if (threadIdx.x == 0) (void)xb_add(&bar[XB_XCNT(b.x)], 1u);
    return b;
}
__device__ __forceinline__ void xcd_barrier_complete(unsigned* bar, unsigned x, unsigned& nloc, unsigned& nx) {
    const unsigned G = gridDim.x * gridDim.y * gridDim.z;
    unsigned sum, cnt, mine, sp = 0u;
    for (;;) {
        sum = 0u; cnt = 0u; mine = 0u;
#pragma unroll
        for (unsigned j = 0; j < 16; ++j) { const unsigned c = xb_ld(&bar[XB_XCNT(j)]); sum += c; cnt += (c > 0u) ? 1u : 0u; mine = (j == x) ? c : mine; }
        if (sum == G) break;
        __builtin_amdgcn_s_sleep(1);
        if ((++sp & 255u) == 0u) { if (xb_ld(&bar[XB_TMO])) break; if (sp > XB_SPIN_CAP) { atomicAdd(&bar[XB_TMO], 1u); break; } }
    }
    nloc = mine > 0u ? mine : 1u; nx = cnt > 0u ? cnt : 1u;
}
__device__ __forceinline__ void xcd_barrier(const XcdBarrier& b) {
    asm volatile("s_waitcnt vmcnt(0)" ::: "memory");
    __syncthreads();
    if (threadIdx.x == 0) {
        unsigned* bar = b.bar;
        __builtin_amdgcn_s_waitcnt(0);
        unsigned nloc = b.st[0], nx = b.st[1];
        if (nloc == 0u) { xcd_barrier_complete(bar, b.x, nloc, nx); b.st[0] = nloc; b.st[1] = nx; }
        const unsigned old = xb_add(&bar[XB_XSUB(b.x)], 1u);
        const unsigned gen = old / nloc;
        if (old + 1u == (gen + 1u) * nloc) {
            __builtin_amdgcn_fence(__ATOMIC_RELEASE, "agent");
            asm volatile("s_waitcnt vmcnt(0)" ::: "memory");
            const unsigned og = xb_add(&bar[XB_TOP], 1u);
            const unsigned tg = og / nx;
            if (og + 1u == (tg + 1u) * nx) xb_add(&bar[XB_TOPGEN], 1u);
            else XB_SPIN(xb_ld(&bar[XB_TOPGEN]) == tg, bar);
            __builtin_amdgcn_fence(__ATOMIC_ACQUIRE, "agent");
            xb_add(&bar[XB_XGEN(b.x)], 1u);
            asm volatile("s_waitcnt vmcnt(0)" ::: "memory");
        } else {
            XB_SPIN(xb_ld(&bar[XB_XGEN(b.x)]) == gen, bar);
            __builtin_amdgcn_fence(__ATOMIC_ACQUIRE, "agent");
            asm volatile("s_waitcnt vmcnt(0)" ::: "memory");
        }
    }
    __syncthreads();
}

__global__ void __launch_bounds__(512, 2) fwd_megakernel(const Params P) {
    extern __shared__ __attribute__((aligned(16))) unsigned char shm[];
    __shared__ uint4 xb_words;
    LAS unsigned char* lds = (LAS unsigned char*)shm;
    unsigned char* ws = P.ws;
    unsigned* xbar = (unsigned*)(ws + OFF_BAR);
    if (threadIdx.x == 0) xb_words = make_uint4(0u, 0u, 0u, 0u);
    __syncthreads();
    XcdBarrier xb = xcd_barrier_post(xbar, (volatile LAS unsigned*)&xb_words);
    float* ss = (float*)(ws + OFF_SUMSQ);
    pg8::StaticOrder S;
#define PH_ON(i) (P.ph_lo <= (i) && (i) < P.ph_hi)
#define PH_SYNC(i) if (P.ph_lo <= (i) && (i) + 1 < P.ph_hi) xcd_barrier(xb);
#if (PHMASK >> 0) & 1
    if (PH_ON(0)) ph_prologue(P, shm);
#endif
    PH_SYNC(0)
#if (PHMASK >> 1) & 1
    if (PH_ON(1)) { pg8::Gemm g{(const bf16_t*)(ws + OFF_XB), (const bf16_t*)(ws + OFF_WIN), NTOK, INC, DM, DM, DM, 0}; S.init(NTOK, INC, gridDim.x, blockIdx.x);
        EpiScaleBf16 E{(bf16_t*)(ws + OFF_Z), INC, ss, nullptr}; pg8::gemm_phase(lds, g, S, E); }
#endif
    PH_SYNC(1)
#if (PHMASK >> 2) & 1
    if (PH_ON(2)) { const bool first = (blockIdx.x >> 3) & 1;
        if (first) wt_convert(P, shm, 2016, 3248);
        ph_pool_diff(P); ph_ret_kv(P, shm);
        if (!first) wt_convert(P, shm, 2016, 3248); }
#endif
    PH_SYNC(2)
#if (PHMASK >> 3) & 1
    if (PH_ON(3)) { pg8::Gemm g{(const bf16_t*)(ws + OFF_DIFF), (const bf16_t*)(ws + OFF_POOLT), NTOK, 1024, 256, 1024, 256, 512}; S.init(NTOK, 1024, gridDim.x, blockIdx.x);
        EpiScaleBf16 E{(bf16_t*)(ws + OFF_MIX), DM, nullptr, P.pool_scale}; pg8::gemm_phase(lds, g, S, E); ph_ret_scan(P); }
#endif
    PH_SYNC(3)
#if (PHMASK >> 4) & 1
    if (PH_ON(4)) { const bool first = (blockIdx.x >> 3) & 1;
        if (first) wt_convert(P, shm, 640, 2016);
        ph_ret_out(P, shm);
        if (!first) wt_convert(P, shm, 640, 2016); }
#endif
    PH_SYNC(4)
#if (PHMASK >> 5) & 1
    if (PH_ON(5)) { pg8::Gemm g{(const bf16_t*)(ws + OFF_MIX), (const bf16_t*)(ws + OFF_WOUT), NTOK, DM, DM, DM, DM, 0}; S.init(NTOK, DM, gridDim.x, blockIdx.x);
        EpiRes<false> E{ws + OFF_XB, (bf16_t*)(ws + OFF_H1B), ss + NTOK}; pg8::gemm_phase(lds, g, S, E); }
#endif
    PH_SYNC(5)
#if (PHMASK >> 6) & 1
    if (PH_ON(6)) { pg8::Gemm g{(const bf16_t*)(ws + OFF_H1B), (const bf16_t*)(ws + OFF_WUP), NTOK, UPC, DM, DM, DM, 0}; S.init(NTOK, UPC, gridDim.x, blockIdx.x);
        EpiUp E{(bf16_t*)(ws + OFF_ACT), (float*)(ws + OFF_EDGE), ss + NTOK, P.conv_w, P.conv_b}; pg8::gemm_phase(lds, g, S, E); }
#endif
    PH_SYNC(6)
#if (PHMASK >> 7) & 1
    if (PH_ON(7)) ph_fixup(P);
#endif
    PH_SYNC(7)
#if (PHMASK >> 8) & 1
    if (PH_ON(8)) { pg8::Gemm g{(const bf16_t*)(ws + OFF_ACT), (const bf16_t*)(ws + OFF_WDOWN), NTOK, DM, DFF, DFF, DFF, 0}; S.init(NTOK, DM, gridDim.x, blockIdx.x);
        EpiRes<false> E{ws + OFF_H1B, (bf16_t*)(ws + OFF_H2B), ss + 2 * NTOK}; pg8::gemm_phase(lds, g, S, E); }
#endif
#if (PHMASK >> 11) & 1
    if (PH_ON(8)) { pg8::Gemm g2{(const bf16_t*)(ws + OFF_PB), (const bf16_t*)(ws + OFF_WPROJ), NTOK, DM, PLE, PLE, PLE, 0}; S.init(NTOK, DM, gridDim.x, blockIdx.x);
        EpiScaleBf16 E2{(bf16_t*)(ws + OFF_PROJ), DM, nullptr, nullptr}; pg8::gemm_phase(lds, g2, S, E2); }
#endif
    PH_SYNC(8)
#if (PHMASK >> 9) & 1
    if (PH_ON(9)) { pg8::Gemm g{(const bf16_t*)(ws + OFF_H2B), (const bf16_t*)(ws + OFF_WGATE), NTOK, DM, DM, DM, DM, 0}; S.init(NTOK, DM, gridDim.x, blockIdx.x);
        EpiGate E{(const bf16_t*)(ws + OFF_H2B), (bf16_t*)(ws + OFF_H3B), (const bf16_t*)(ws + OFF_PROJ), ss + 2 * NTOK, ss + 3 * NTOK}; pg8::gemm_phase(lds, g, S, E); }
#endif
    PH_SYNC(9)
#if (PHMASK >> 10) & 1
    if (PH_ON(10)) ph_final(P);
#endif
    if (P.ph_hi > 1000) cg::this_grid().sync();
}

constexpr int NPHASES = 11;

extern "C" void kernel_launch(void* const* d_in, const int* in_sizes, int n_in, void* d_out, int out_size, void* d_ws, size_t ws_size, hipStream_t stream) {
    (void)in_sizes; (void)n_in; (void)out_size; (void)ws_size;
    static int grid_blocks = 0;
    if (!grid_blocks) {
        (void)hipFuncSetAttribute((const void*)fwd_megakernel, hipFuncAttributeMaxDynamicSharedMemorySize, LDS_BYTES);
        int dev = 0, cus = 0, per_cu = 0;
        (void)hipGetDevice(&dev);
        (void)hipDeviceGetAttribute(&cus, hipDeviceAttributeMultiprocessorCount, dev);
        (void)hipOccupancyMaxActiveBlocksPerMultiprocessor(&per_cu, fwd_megakernel, 512, LDS_BYTES);
        if (per_cu < 1) per_cu = 1;
        if (per_cu > 1) per_cu = 1;
        grid_blocks = cus * per_cu;
    }
    Params P;
    memset(&P, 0, sizeof(P));
    P.x = (const float*)d_in[0]; P.p = (const float*)d_in[1]; P.norm1_w = (const float*)d_in[2]; P.w_in = (const float*)d_in[3];
    P.pool_w = (const float*)d_in[4]; P.pool_scale = (const float*)d_in[5]; P.ret_gn_w = (const float*)d_in[6]; P.w_out = (const float*)d_in[7];
    P.norm2_w = (const float*)d_in[8]; P.w_up = (const float*)d_in[9]; P.conv_w = (const float*)d_in[10]; P.conv_b = (const float*)d_in[11];
    P.w_down = (const float*)d_in[12]; P.norm3_w = (const float*)d_in[13]; P.ple_gate_w = (const float*)d_in[14]; P.ple_proj_w = (const float*)d_in[15];
    P.final_norm_w = (const float*)d_in[16];
    P.out = (float*)d_out; P.ws = (unsigned char*)d_ws;
    for (int i = 0; i < 64; ++i) { const float e = (float)(2 * i) / 128.0f; const float pw = powf(10000.0f, e); P.inv_freq[i] = 1.0f / pw; }
    for (int h = 0; h < 8; ++h) { const float gamma = 1.0f - exp2f(-5.0f - (float)h); P.log2g[h] = (float)std::log2((double)gamma); }
#if MK_SINGLE
    P.ph_lo = 0; P.ph_hi = NPHASES;
    void* args[] = {(void*)&P};
    (void)hipMemsetAsync((unsigned char*)d_ws + OFF_BAR, 0, XCD_BAR_WORDS * 4, stream);
    hipError_t e = hipLaunchCooperativeKernel((const void*)fwd_megakernel, dim3(grid_blocks), dim3(512), args, LDS_BYTES, stream);
    if (e != hipSuccess) fprintf(stderr, "cooperative launch failed: %s (grid %d)\n", hipGetErrorString(e), grid_blocks);
#else
    for (int ph = 0; ph < NPHASES; ++ph) {
        P.ph_lo = ph; P.ph_hi = ph + 1;
        hipLaunchKernelGGL(fwd_megakernel, dim3(grid_blocks), dim3(512), LDS_BYTES, stream, P);
    }
#endif
}
```

```cpp
#include <hip/hip_runtime.h>
#include <hip/hip_cooperative_groups.h>
#include <cmath>
#include <cstdio>
#include <cstring>
namespace cg = cooperative_groups;

#ifndef PHMASK
#define PHMASK 0xfff
#endif
#ifndef MK_SINGLE
#define MK_SINGLE 1
#endif

#define LAS __attribute__((address_space(3)))
typedef unsigned short bf16_t;
typedef short bf16x8 __attribute__((ext_vector_type(8)));
typedef float f32x4 __attribute__((ext_vector_type(4)));
typedef unsigned u32x4 __attribute__((ext_vector_type(4)));
typedef unsigned u32x2 __attribute__((ext_vector_type(2)));

constexpr int NTOK = 16384, DM = 2048, SEQ = 2048, INC = 5120, DFF = 5504, UPC = 11008, PLE = 256;
constexpr float NORM_EPS = 1e-6f, GN_EPS = 1e-5f;
constexpr size_t MiB = 1048576;
constexpr size_t OFF_WIN = 0, OFF_WPROJ = 20 * MiB, OFF_POOLT = 21 * MiB, OFF_WOUT = 22 * MiB, OFF_WUP = 30 * MiB,
                 OFF_WDOWN = 73 * MiB, OFF_WGATE = 95 * MiB, OFF_SUMSQ = 103 * MiB, OFF_COS = 103 * MiB + 262144,
                 OFF_SIN = OFF_COS + 524288, OFF_BAR = 104 * MiB + 524288, OFF_PB = 105 * MiB,
                 OFF_XB = 113 * MiB, OFF_Z = 177 * MiB, OFF_DIFF = 337 * MiB, OFF_KVT = 369 * MiB  , OFF_RT = 401 * MiB,
                 OFF_MIX = 433 * MiB, OFF_H1B = 177 * MiB, OFF_ACT = 241 * MiB, OFF_EDGE = 413 * MiB,
                 OFF_H2B = 113 * MiB, OFF_PROJ = 448 * MiB, OFF_H3B = 177 * MiB;
constexpr int LDS_BYTES = 131072 + 16384;
constexpr int EPI_LDS = 131072;

struct Params {
    const float *x, *p, *norm1_w, *w_in, *pool_w, *pool_scale, *ret_gn_w, *w_out, *norm2_w, *w_up, *conv_w, *conv_b, *w_down,
        *norm3_w, *ple_gate_w, *ple_proj_w, *final_norm_w;
    float* out;
    unsigned char* ws;
    float inv_freq[64];
    float log2g[8];
    int ph_lo, ph_hi;
};

typedef __bf16 bf16x2_t __attribute__((ext_vector_type(2)));
typedef float f32x2_t __attribute__((ext_vector_type(2)));
__device__ __forceinline__ unsigned cvt_pk_bf16(float lo, float hi) { const f32x2_t v = {lo, hi}; return __builtin_bit_cast(unsigned, __builtin_convertvector(v, bf16x2_t)); }
__device__ __forceinline__ float bflo(unsigned w) { return __uint_as_float(w << 16); }
__device__ __forceinline__ float bfhi(unsigned w) { return __uint_as_float(w & 0xffff0000u); }
__device__ __forceinline__ float sigmoidf_(float v) { return __builtin_amdgcn_rcpf(1.0f + __expf(-v)); }
template <int CTRL> __device__ __forceinline__ float dpp_f(float v) { return __builtin_bit_cast(float, __builtin_amdgcn_update_dpp(0, __builtin_bit_cast(int, v), CTRL, 0xf, 0xf, true)); }
template <int CTRL> __device__ __forceinline__ float dpp_o(float old, float v) { return __builtin_bit_cast(float, __builtin_amdgcn_update_dpp(__builtin_bit_cast(int, old), __builtin_bit_cast(int, v), CTRL, 0xf, 0xf, false)); }
__device__ __forceinline__ float wave_sum(float s) {
    s += __shfl_xor(s, 32); s += __shfl_xor(s, 16); s += __shfl_xor(s, 8); s += __shfl_xor(s, 4); s += __shfl_xor(s, 2); s += __shfl_xor(s, 1); return s;
}

namespace pg8 {
constexpr int BM = 256, BK = 64, HALF = 128, HTB = HALF * BK * 2, NXCD = 8, WGM = 8;
__device__ __forceinline__ int lds_byte(int r, int c) { const int st = (r >> 4) * 2 + (c >> 5), rr = r & 15, cc = c & 31, ob = rr * 64 + cc * 2; return st * 1024 + (ob ^ (((ob >> 9) & 1) << 5)); }
__device__ __forceinline__ void stage_rc(int b, int& R, int& C) { const int st = b / 1024, sb = b % 1024, swz = sb ^ (((sb >> 9) & 1) << 5); R = (st >> 1) * 16 + swz / 64; C = (st & 1) * 32 + (swz % 64) / 2; }
__device__ __forceinline__ int perm32(int rho) { const int n = rho >> 4, i = rho & 15; return 8 * (i >> 2) + 4 * n + (i & 3); }

struct Unit { int pm, pn; };
struct Gemm { const bf16_t* A; const bf16_t* Bt; int M, N, K, lda, ldb, a_pn_off; };

struct StaticOrder {
    int nM, nN, nwg, G, c;
    __device__ void init(int M, int N, int G_, int c_) { nM = M / BM; nN = N / BM; nwg = nM * nN; G = G_; c = c_; }
    __device__ bool next(int i, Unit& u) const {
        const long L = (long)i * G + c; if (L >= nwg) return false;
        int wgid = (int)L; { const int q = nwg / NXCD, r = nwg % NXCD, xcd = wgid % NXCD, off = wgid / NXCD; wgid = (xcd < r ? xcd * (q + 1) : r * (q + 1) + (xcd - r) * q) + off; }
        const int nig = WGM * nN, gid = wgid / nig, fm = gid * WGM, gsz = (nM - fm) < WGM ? (nM - fm) : WGM;
        u.pm = fm + ((wgid % nig) % gsz); u.pn = (wgid % nig) / gsz; return true;
    }
};

template <class Epi>
__device__ __forceinline__ void gemm_phase(LAS unsigned char* lds, const Gemm g, const StaticOrder& S, const Epi& E) {
    int tid_ = threadIdx.x; asm volatile("" : "+v"(tid_));
    const int tid = tid_, wid = __builtin_amdgcn_readfirstlane(tid >> 6), lane = tid & 63, wr = wid >> 2, wc = wid & 3, fr = lane & 15, fq = lane >> 4;
    const int K = g.K, nt = K / BK;
    unsigned voffA[2], voffB[2];
#pragma unroll
    for (int i = 0; i < 2; ++i) { int R, C; stage_rc(tid * 16 + i * 8192, R, C); const int Rb = (R & ~31) + perm32(R & 31);
        voffA[i] = (unsigned)(R * g.lda + C) * 2u; voffB[i] = (unsigned)(Rb * g.ldb + C) * 2u; }
    const size_t kstep = (size_t)(BK * 2);
    const size_t hstepA = (size_t)HALF * g.lda * 2, hstepB = (size_t)HALF * g.ldb * 2;
    const size_t tstepA = 2 * hstepA, tstepB = 2 * hstepB;
    const unsigned ldsw = (unsigned)wid * 1024u;
    const int aoff = lds_byte(wr * 64 + fr, fq * 8), boff = lds_byte(wc * 32 + fr, fq * 8);
#define PG8_SA(b, h) (((b) * 2 + (h)) * HTB)
#define PG8_SB(b, h) ((4 + (b) * 2 + (h)) * HTB)
#define PG8_STAGE(bufoff, gbase, voff) do { _Pragma("unroll") for (int _i = 0; _i < 2; ++_i) \
        __builtin_amdgcn_global_load_lds((const unsigned*)((const char*)(gbase) + (voff)[_i]), (LAS unsigned*)(lds + (bufoff) + ldsw + _i * 8192), 16, 0, 0); } while (0)
#define PG8_LDA(dst, b, h) do { _Pragma("unroll") for (int m = 0; m < 4; ++m) _Pragma("unroll") for (int k = 0; k < 2; ++k) dst[m][k] = *(const LAS bf16x8*)(lds + PG8_SA(b, h) + aoff + m * 2048 + k * 1024); } while (0)
#define PG8_LDB(dst, b, h) do { _Pragma("unroll") for (int n = 0; n < 2; ++n) _Pragma("unroll") for (int k = 0; k < 2; ++k) dst[n][k] = *(const LAS bf16x8*)(lds + PG8_SB(b, h) + boff + n * 2048 + k * 1024); } while (0)
#define PG8_MMA(ai, bj, At, Bt) do { __builtin_amdgcn_s_setprio(1); _Pragma("unroll") for (int m = 0; m < 4; ++m) _Pragma("unroll") for (int n = 0; n < 2; ++n) _Pragma("unroll") for (int k = 0; k < 2; ++k) \
        acc[ai][bj][m][n] = __builtin_amdgcn_mfma_f32_16x16x32_bf16(Bt[n][k], At[m][k], acc[ai][bj][m][n], 0, 0, 0); __builtin_amdgcn_s_setprio(0); } while (0)
#define PG8_WAIT_V(n) asm volatile("s_waitcnt vmcnt(" #n ")" ::: "memory")
#define PG8_WAIT_L(n) asm volatile("s_waitcnt lgkmcnt(" #n ")" ::: "memory")
#define PG8_BAR __builtin_amdgcn_s_barrier()
#define PG8_SCHED __builtin_amdgcn_sched_barrier(0)
    Unit cur, nxt; int ui = 0, ubuf = 0;
    if (!S.next(0, cur)) return;
    E.prefetch(lds, cur, ubuf, wid, lane);
    f32x4 acc[2][2][4][2];
#pragma unroll
    for (int a = 0; a < 2; ++a)
#pragma unroll
        for (int b = 0; b < 2; ++b)
#pragma unroll
            for (int m = 0; m < 4; ++m)
#pragma unroll
                for (int n = 0; n < 2; ++n) acc[a][b][m][n] = (f32x4){0.f, 0.f, 0.f, 0.f};
    bf16x8 At[4][2], B0[2][2], B1[2][2];
    const char* cA = (const char*)g.A + (size_t)cur.pm * tstepA + (size_t)cur.pn * g.a_pn_off; const char* cB = (const char*)g.Bt + (size_t)cur.pn * tstepB;
    PG8_STAGE(PG8_SB(0, 0), cB, voffB); PG8_STAGE(PG8_SA(0, 0), cA, voffA); PG8_STAGE(PG8_SB(0, 1), cB + hstepB, voffB); PG8_STAGE(PG8_SA(0, 1), cA + hstepA, voffA);
    if (wr == 1) PG8_BAR;
    PG8_WAIT_V(4); PG8_BAR;
    PG8_STAGE(PG8_SB(1, 0), cB + kstep, voffB); PG8_STAGE(PG8_SA(1, 0), cA + kstep, voffA); PG8_STAGE(PG8_SB(1, 1), cB + hstepB + kstep, voffB);
    PG8_WAIT_V(6); PG8_BAR;
    for (;;) {
        const bool has_next = S.next(ui + 1, nxt);
        const char* nA = has_next ? (const char*)g.A + (size_t)nxt.pm * tstepA + (size_t)nxt.pn * g.a_pn_off : cA; const char* nB = has_next ? (const char*)g.Bt + (size_t)nxt.pn * tstepB : cB;
        for (int t = 0; t < nt; t += 2) {
            const bool last = (t == nt - 2);
            const char* a1 = cA + (size_t)(t + 1) * kstep;
            const char* a2 = last ? nA : cA + (size_t)(t + 2) * kstep; const char* b2 = last ? nB : cB + (size_t)(t + 2) * kstep;
            const char* a3 = a2 + kstep; const char* b3 = b2 + kstep;
            PG8_LDB(B0, 0, 0); PG8_SCHED; PG8_LDA(At, 0, 0); PG8_STAGE(PG8_SA(1, 1), a1 + hstepA, voffA);
            PG8_WAIT_L(8); PG8_BAR; PG8_WAIT_L(0); PG8_MMA(0, 0, At, B0); PG8_BAR; PG8_SCHED;
            PG8_LDB(B1, 0, 1); PG8_STAGE(PG8_SB(0, 0), b2, voffB);
            PG8_BAR; PG8_WAIT_L(0); PG8_MMA(0, 1, At, B1); PG8_BAR;
            PG8_LDA(At, 0, 1); PG8_STAGE(PG8_SA(0, 0), a2, voffA);
            PG8_BAR; PG8_WAIT_L(0); PG8_MMA(1, 0, At, B0); PG8_BAR; PG8_SCHED;
            PG8_STAGE(PG8_SB(0, 1), b2 + hstepB, voffB);
            PG8_WAIT_V(6); PG8_BAR; PG8_MMA(1, 1, At, B1); PG8_BAR;
            PG8_LDB(B0, 1, 0); PG8_SCHED; PG8_LDA(At, 1, 0); PG8_STAGE(PG8_SA(0, 1), a2 + hstepA, voffA);
            PG8_WAIT_L(8); PG8_BAR; PG8_WAIT_L(0); PG8_MMA(0, 0, At, B0); PG8_BAR; PG8_SCHED;
            PG8_LDB(B1, 1, 1); PG8_STAGE(PG8_SB(1, 0), b3, voffB);
            PG8_BAR; PG8_WAIT_L(0); PG8_MMA(0, 1, At, B1); PG8_BAR;
            PG8_LDA(At, 1, 1); PG8_STAGE(PG8_SA(1, 0), a3, voffA);
            PG8_BAR; PG8_WAIT_L(0); PG8_MMA(1, 0, At, B0); PG8_BAR; PG8_SCHED;
            PG8_STAGE(PG8_SB(1, 1), b3 + hstepB, voffB);
            PG8_WAIT_V(6); PG8_BAR; PG8_MMA(1, 1, At, B1); PG8_BAR;
        }
        E(acc, cur, wr, wc, fr, fq, lds, ubuf);
        if (!has_next) break;
        ubuf ^= 1; E.prefetch(lds, nxt, ubuf, wid, lane);
#pragma unroll
        for (int a = 0; a < 2; ++a)
#pragma unroll
            for (int b = 0; b < 2; ++b)
#pragma unroll
                for (int m = 0; m < 4; ++m)
#pragma unroll
                    for (int n = 0; n < 2; ++n) acc[a][b][m][n] = (f32x4){0.f, 0.f, 0.f, 0.f};
        cur = nxt; cA = nA; cB = nB; ++ui;
    }
    PG8_WAIT_V(0);
    if (wr == 0) PG8_BAR;
    PG8_BAR;
#undef PG8_SA
#undef PG8_SB
#undef PG8_STAGE
#undef PG8_LDA
#undef PG8_LDB
#undef PG8_MMA
#undef PG8_WAIT_V
#undef PG8_WAIT_L
#undef PG8_BAR
#undef PG8_SCHED
}
}
using pg8::Unit;

__device__ __forceinline__ f32x4 bf4lo(const u32x4 w) { return (f32x4){bflo(w.x), bfhi(w.x), bflo(w.y), bfhi(w.y)}; }
__device__ __forceinline__ f32x4 bf4hi(const u32x4 w) { return (f32x4){bflo(w.z), bfhi(w.z), bflo(w.w), bfhi(w.w)}; }
__device__ __forceinline__ u32x4 pack8(const f32x4 v0, const f32x4 v1) { u32x4 w; w.x = cvt_pk_bf16(v0[0], v0[1]); w.y = cvt_pk_bf16(v0[2], v0[3]); w.z = cvt_pk_bf16(v1[0], v1[1]); w.w = cvt_pk_bf16(v1[2], v1[3]); return w; }
__device__ __forceinline__ float sq8(const f32x4 v0, const f32x4 v1) { return v0[0] * v0[0] + v0[1] * v0[1] + v0[2] * v0[2] + v0[3] * v0[3] + v1[0] * v1[0] + v1[1] * v1[1] + v1[2] * v1[2] + v1[3] * v1[3]; }
struct EpiScaleBf16 {
    bf16_t* O; int ldc; const float* ss; const float* cscale;
    __device__ __forceinline__ void prefetch(LAS unsigned char*, const Unit&, int, int, int) const {}
    __device__ __forceinline__ void operator()(const f32x4 (&acc)[2][2][4][2], const Unit& u, int wr, int wc, int fr, int fq, LAS unsigned char* lds, int ubuf) const {
        const int row0 = u.pm * 256 + wr * 64 + fr, col0 = u.pn * 256 + wc * 32 + 8 * fq;
        f32x4 cs[2][2]; float rsv[2][4];
#pragma unroll
        for (int bj = 0; bj < 2; ++bj)
#pragma unroll
            for (int n = 0; n < 2; ++n) cs[bj][n] = cscale ? *(const f32x4*)(cscale + col0 + bj * 128 + 4 * n) : (f32x4){1.f, 1.f, 1.f, 1.f};
#pragma unroll
        for (int ai = 0; ai < 2; ++ai)
#pragma unroll
            for (int m = 0; m < 4; ++m) rsv[ai][m] = ss ? ss[row0 + ai * 128 + m * 16] : 0.f;
        __builtin_amdgcn_sched_barrier(0);
#pragma unroll
        for (int ai = 0; ai < 2; ++ai)
#pragma unroll
            for (int m = 0; m < 4; ++m) {
                const int row = row0 + ai * 128 + m * 16;
                const float rs = ss ? rsqrtf(rsv[ai][m] * (1.0f / 2048.0f) + NORM_EPS) : 1.0f;
                bf16_t* rowp = O + (size_t)row * ldc + col0;
#pragma unroll
                for (int bj = 0; bj < 2; ++bj) *(u32x4*)(rowp + bj * 128) = pack8(acc[ai][bj][m][0] * rs * cs[bj][0], acc[ai][bj][m][1] * rs * cs[bj][1]);
            }
    }
};
template <bool RF32> struct EpiRes {
    const void* res; bf16_t* ob; float* ssq;
    __device__ __forceinline__ void prefetch(LAS unsigned char*, const Unit&, int, int, int) const {}
    __device__ __forceinline__ void operator()(const f32x4 (&acc)[2][2][4][2], const Unit& u, int wr, int wc, int fr, int fq, LAS unsigned char* lds, int ubuf) const {
        const int row0 = u.pm * 256 + wr * 64 + fr, col0 = u.pn * 256 + wc * 32 + 8 * fq;
        if constexpr (RF32) {
#pragma unroll
            for (int ai = 0; ai < 2; ++ai) {
                f32x4 r0[4][2], r1[4][2];
#pragma unroll
                for (int m = 0; m < 4; ++m)
#pragma unroll
                    for (int bj = 0; bj < 2; ++bj) {
                        const size_t o = (size_t)(row0 + ai * 128 + m * 16) * DM + col0 + bj * 128;
                        r0[m][bj] = *(const f32x4*)((const float*)res + o); r1[m][bj] = *(const f32x4*)((const float*)res + o + 4);
                    }
                __builtin_amdgcn_sched_barrier(0);
#pragma unroll
                for (int m = 0; m < 4; ++m) {
                    const int row = row0 + ai * 128 + m * 16;
                    float s = 0.f;
#pragma unroll
                    for (int bj = 0; bj < 2; ++bj) {
                        const size_t o = (size_t)row * DM + col0 + bj * 128;
                        const f32x4 v0 = acc[ai][bj][m][0] + r0[m][bj], v1 = acc[ai][bj][m][1] + r1[m][bj];
                        *(u32x4*)(ob + o) = pack8(v0, v1);
                        s += sq8(v0, v1);
                    }
                    s += __shfl_xor(s, 16); s += __shfl_xor(s, 32);
                    if (fq == 0) unsafeAtomicAdd(ssq + row, s);
                }
            }
        } else {
            u32x4 pw[2][4][2];
#pragma unroll
            for (int ai = 0; ai < 2; ++ai)
#pragma unroll
                for (int m = 0; m < 4; ++m)
#pragma unroll
                    for (int bj = 0; bj < 2; ++bj) pw[ai][m][bj] = *(const u32x4*)((const bf16_t*)res + (size_t)(row0 + ai * 128 + m * 16) * DM + col0 + bj * 128);
            __builtin_amdgcn_sched_barrier(0);
#pragma unroll
            for (int ai = 0; ai < 2; ++ai)
#pragma unroll
                for (int m = 0; m < 4; ++m) {
                    const int row = row0 + ai * 128 + m * 16;
                    float s = 0.f;
#pragma unroll
                    for (int bj = 0; bj < 2; ++bj) {
                        const size_t o = (size_t)row * DM + col0 + bj * 128;
                        const f32x4 v0 = acc[ai][bj][m][0] + bf4lo(pw[ai][m][bj]), v1 = acc[ai][bj][m][1] + bf4hi(pw[ai][m][bj]);
                        *(u32x4*)(ob + o) = pack8(v0, v1);
                        s += sq8(v0, v1);
                    }
                    s += __shfl_xor(s, 16); s += __shfl_xor(s, 32);
                    if (fq == 0) unsafeAtomicAdd(ssq + row, s);
                }
        }
    }
};
struct EpiGate {
    const bf16_t* h2b; bf16_t* h3b; const bf16_t* proj; const float* ss3; float* ss4;
    __device__ __forceinline__ void prefetch(LAS unsigned char*, const Unit&, int, int, int) const {}
    __device__ __forceinline__ void operator()(const f32x4 (&acc)[2][2][4][2], const Unit& u, int wr, int wc, int fr, int fq, LAS unsigned char* lds, int ubuf) const {
        const int row0 = u.pm * 256 + wr * 64 + fr, col0 = u.pn * 256 + wc * 32 + 8 * fq;
#pragma unroll
        for (int ai = 0; ai < 2; ++ai) {
            u32x4 hw[4][2], pw[4][2]; float rsv[4];
#pragma unroll
            for (int m = 0; m < 4; ++m) {
                rsv[m] = ss3[row0 + ai * 128 + m * 16];
#pragma unroll
                for (int bj = 0; bj < 2; ++bj) {
                    const size_t o = (size_t)(row0 + ai * 128 + m * 16) * DM + col0 + bj * 128;
                    hw[m][bj] = *(const u32x4*)(h2b + o); pw[m][bj] = *(const u32x4*)(proj + o);
                }
            }
            __builtin_amdgcn_sched_barrier(0);
#pragma unroll
            for (int m = 0; m < 4; ++m) {
                const int row = row0 + ai * 128 + m * 16;
                const float rs = rsqrtf(rsv[m] * (1.0f / 2048.0f) + NORM_EPS);
                float s = 0.f;
#pragma unroll
                for (int bj = 0; bj < 2; ++bj) {
                    const size_t o = (size_t)row * DM + col0 + bj * 128;
                    const f32x4 r0 = bf4lo(hw[m][bj]), r1 = bf4hi(hw[m][bj]), p0 = bf4lo(pw[m][bj]), p1 = bf4hi(pw[m][bj]);
                    f32x4 v0, v1;
#pragma unroll
                    for (int j = 0; j < 4; ++j) { v0[j] = r0[j] + sigmoidf_(acc[ai][bj][m][0][j] * rs) * p0[j]; v1[j] = r1[j] + sigmoidf_(acc[ai][bj][m][1][j] * rs) * p1[j]; }
                    *(u32x4*)(h3b + o) = pack8(v0, v1);
                    s += sq8(v0, v1);
                }
                s += __shfl_xor(s, 16); s += __shfl_xor(s, 32);
                if (fq == 0) unsafeAtomicAdd(ss4 + row, s);
            }
        }
    }
};
struct EpiUp {
    bf16_t* act; float* edge; const float* ss2; const float* conv_w; const float* conv_b;
    __device__ __forceinline__ void prefetch(LAS unsigned char* lds, const Unit& u, int ubuf, int wid, int lane) const {
        if (wid < 5) {
            const int p = wid * 64 + lane, a = p >> 5, wi = p & 31;
            const float* src;
            if (a < 8) { const int par = a & 3, f = (a >> 2) * DFF + u.pn * 128 + 4 * wi; src = (par < 3) ? conv_w + par * UPC + f : conv_b + f; }
            else src = ss2 + u.pm * 256 + (p - 256) * 4;
            __builtin_amdgcn_global_load_lds((const unsigned*)src, (LAS unsigned*)(lds + EPI_LDS + ubuf * 8192 + wid * 1024), 16, 0, 0);
        }
    }
    __device__ __forceinline__ void operator()(const f32x4 (&acc)[2][2][4][2], const Unit& u, int wr, int wc, int fr, int fq, LAS unsigned char* lds, int ubuf) const {
        const LAS float* pp = (const LAS float*)(lds + EPI_LDS + ubuf * 8192);
        float rsv[2][4];
#pragma unroll
        for (int ai = 0; ai < 2; ++ai)
#pragma unroll
            for (int m = 0; m < 4; ++m) rsv[ai][m] = rsqrtf(pp[1024 + ai * 128 + wr * 64 + m * 16 + fr] * (1.0f / 2048.0f) + NORM_EPS);
#pragma unroll
        for (int n = 0; n < 2; ++n) {
            const int cf = wc * 32 + 8 * fq + 4 * n;
            const int f = u.pn * 128 + cf;
            const f32x4 w0g = *(const LAS f32x4*)(pp + cf), w1g = *(const LAS f32x4*)(pp + 128 + cf), w2g = *(const LAS f32x4*)(pp + 256 + cf), bg = *(const LAS f32x4*)(pp + 384 + cf);
            const f32x4 w0v = *(const LAS f32x4*)(pp + 512 + cf), w1v = *(const LAS f32x4*)(pp + 640 + cf), w2v = *(const LAS f32x4*)(pp + 768 + cf), bv = *(const LAS f32x4*)(pp + 896 + cf);
#pragma unroll
            for (int ai = 0; ai < 2; ++ai) {
                const int run = u.pm * 4 + ai * 2 + wr;
                float* eg = edge + (size_t)run * 4 * UPC + u.pn * 256 + cf;
                f32x4 pG = {0.f, 0.f, 0.f, 0.f}, pV = {0.f, 0.f, 0.f, 0.f};
#pragma unroll
                for (int m = 0; m < 4; ++m) {
                    const int row = run * 64 + m * 16 + fr;
                    const float rs = rsv[ai][m];
                    const f32x4 G = acc[ai][0][m][n] * rs, V = acc[ai][1][m][n] * rs;
                    if (m == 0 && fr < 2) { *(f32x4*)(eg + (size_t)fr * UPC) = G; *(f32x4*)(eg + (size_t)fr * UPC + 128) = V; }
                    if (m == 3 && fr >= 14) { *(f32x4*)(eg + (size_t)(fr - 12) * UPC) = G; *(f32x4*)(eg + (size_t)(fr - 12) * UPC + 128) = V; }
                    f32x4 g1, g2, v1, v2;
#pragma unroll
                    for (int j = 0; j < 4; ++j) {
                        g1[j] = dpp_o<0x111>(dpp_f<0x10F>(pG[j]), G[j]); g2[j] = dpp_o<0x112>(dpp_f<0x10E>(pG[j]), G[j]);
                        v1[j] = dpp_o<0x111>(dpp_f<0x10F>(pV[j]), V[j]); v2[j] = dpp_o<0x112>(dpp_f<0x10E>(pV[j]), V[j]);
                    }
                    const f32x4 gate = bg + w2g * G + w1g * g1 + w0g * g2;
                    const f32x4 val = bv + w2v * V + w1v * v1 + w0v * v2;
                    f32x4 a;
#pragma unroll
                    for (int j = 0; j < 4; ++j) a[j] = gate[j] * sigmoidf_(gate[j]) * val[j];
                    u32x2 w; w.x = cvt_pk_bf16(a[0], a[1]); w.y = cvt_pk_bf16(a[2], a[3]);
                    *(u32x2*)(act + (size_t)row * DFF + f) = w;
                    pG = G; pV = V;
                }
            }
        }
    }
};

struct WtJob { const float* W; const float* scale; bf16_t* Bt; int ldw, ldb, k0, n0, up; };
__device__ __forceinline__ bool wt_job(const Params& P, int id, WtJob& j) {
    unsigned char* ws = P.ws;
    const int T0 = 640, T1 = T0 + 1376, T2 = T1 + 688, T3 = T2 + 256, T4 = T3 + 256, T5 = T4 + 32, T6 = T5 + 16;
    if (id >= T6) return false;
    j.up = 0;
    if (id < T0) { const int nt = id % 20, kt = id / 20; j = WtJob{P.w_in, P.norm1_w, (bf16_t*)(ws + OFF_WIN), INC, DM, kt * 64, nt * 256, 0}; }
    else if (id < T1) { const int l = id - T0, nt = l % 43, kt = l / 43; j = WtJob{P.w_up, P.norm2_w, (bf16_t*)(ws + OFF_WUP), UPC, DM, kt * 64, nt * 256, 1}; }
    else if (id < T2) { const int l = id - T1, nt = l % 8, kt = l / 8; j = WtJob{P.w_down, nullptr, (bf16_t*)(ws + OFF_WDOWN), DM, DFF, kt * 64, nt * 256, 0}; }
    else if (id < T3) { const int l = id - T2, nt = l % 8, kt = l / 8; j = WtJob{P.w_out, nullptr, (bf16_t*)(ws + OFF_WOUT), DM, DM, kt * 64, nt * 256, 0}; }
    else if (id < T4) { const int l = id - T3, nt = l % 8, kt = l / 8; j = WtJob{P.ple_gate_w, P.norm3_w, (bf16_t*)(ws + OFF_WGATE), DM, DM, kt * 64, nt * 256, 0}; }
    else if (id < T5) { const int l = id - T4, nt = l % 8, kt = l / 8; j = WtJob{P.ple_proj_w, nullptr, (bf16_t*)(ws + OFF_WPROJ), DM, PLE, kt * 64, nt * 256, 0}; }
    else { const int l = id - T5, g = l >> 2, kt = l & 3; j = WtJob{P.pool_w + g * 65536, nullptr, (bf16_t*)(ws + OFF_POOLT) + g * 65536, 256, 256, kt * 64, 0, 0}; }
    return true;
}
__device__ __forceinline__ void wt_load(const WtJob& j, f32x4 (&v)[8]) {
    const int c4 = (threadIdx.x & 63) * 4, r = threadIdx.x >> 6;
#pragma unroll
    for (int i = 0; i < 8; ++i) v[i] = *(const f32x4*)(j.W + (size_t)(j.k0 + r + 8 * i) * j.ldw + j.n0 + c4);
}
__device__ __forceinline__ void wt_put(const WtJob& j, const f32x4 (&v)[8], float* tile) {
    const int c4 = (threadIdx.x & 63) * 4, r = threadIdx.x >> 6;
#pragma unroll
    for (int i = 0; i < 8; ++i) { const int k = r + 8 * i; const float sc = j.scale ? j.scale[j.k0 + k] : 1.0f; *(f32x4*)(tile + k * 260 + (c4 ^ (4 * i))) = v[i] * sc; }
}
__device__ __forceinline__ void wt_store(const WtJob& j, const float* tile) {
#pragma unroll
    for (int it = 0; it < 4; ++it) {
        const int item = threadIdx.x + 512 * it, n = item >> 3, ko = item & 7; float v[8];
#pragma unroll
        for (int i = 0; i < 8; ++i) v[i] = tile[(ko * 8 + i) * 260 + (n ^ (4 * ko))];
        int nn = j.n0 + n;
        if (j.up) { const int half = nn >= DFF ? 1 : 0, f = nn - half * DFF; nn = 256 * (f >> 7) + 128 * half + (f & 127); }
        u32x4 w; w.x = cvt_pk_bf16(v[0], v[1]); w.y = cvt_pk_bf16(v[2], v[3]); w.z = cvt_pk_bf16(v[4], v[5]); w.w = cvt_pk_bf16(v[6], v[7]);
        *(u32x4*)(j.Bt + (size_t)nn * j.ldb + j.k0 + ko * 8) = w;
    }
}

__device__ void wt_convert(const Params& P, unsigned char* shm, int lo, int hi) {
    float* tile = (float*)shm; WtJob cur, nxt; f32x4 v[8];
    int id = lo + blockIdx.x; bool have = id < hi && wt_job(P, id, cur);
    if (have) wt_load(cur, v);
    while (have) {
        wt_put(cur, v, tile);
        __syncthreads();
        id += gridDim.x; const bool hn = id < hi && wt_job(P, id, nxt);
        if (hn) wt_load(nxt, v);
        wt_store(cur, tile);
        __syncthreads();
        cur = nxt; have = hn;
    }
}
__device__ void ph_prologue(const Params& P, unsigned char* shm) {
    const int tid = threadIdx.x, lane = tid & 63, wid = tid >> 6;
    const int gw = blockIdx.x * 8 + wid, nw = gridDim.x * 8;
    const int gt = blockIdx.x * 512 + tid, ntot = gridDim.x * 512;
    unsigned char* ws = P.ws;
    { bf16_t* xb = (bf16_t*)(ws + OFF_XB); float* ss1 = (float*)(ws + OFF_SUMSQ);
      for (int row = gw; row < NTOK; row += nw) {
          const f32x4* src = (const f32x4*)(P.x + (size_t)row * DM); u32x2* dst = (u32x2*)(xb + (size_t)row * DM); float s = 0.f;
#pragma unroll
          for (int i = 0; i < 8; ++i) { const f32x4 v = src[i * 64 + lane]; s += v[0] * v[0] + v[1] * v[1] + v[2] * v[2] + v[3] * v[3];
              u32x2 w; w.x = cvt_pk_bf16(v[0], v[1]); w.y = cvt_pk_bf16(v[2], v[3]); dst[i * 64 + lane] = w; }
          s = wave_sum(s); if (lane == 0) ss1[row] = s; } }
    { const f32x4* src = (const f32x4*)P.p; u32x2* dst = (u32x2*)(ws + OFF_PB);
      for (int i = gt; i < NTOK * PLE / 4; i += 4 * ntot) {
          f32x4 v[4];
#pragma unroll
          for (int k = 0; k < 4; ++k) { const int j = i + k * ntot; v[k] = src[j < NTOK * PLE / 4 ? j : i]; }
#pragma unroll
          for (int k = 0; k < 4; ++k) { const int j = i + k * ntot; u32x2 w; w.x = cvt_pk_bf16(v[k][0], v[k][1]); w.y = cvt_pk_bf16(v[k][2], v[k][3]); if (j < NTOK * PLE / 4) dst[j] = w; } } }
    { float* ss = (float*)(ws + OFF_SUMSQ) + NTOK; for (int i = gt; i < 3 * NTOK; i += ntot) ss[i] = 0.f; }
    { float* ct = (float*)(ws + OFF_COS); float* st = (float*)(ws + OFF_SIN);
      for (int i = gt; i < SEQ * 64; i += ntot) { const int pos = i >> 6, fi = i & 63; const float ang = (float)pos * P.inv_freq[fi];
          double rev = (double)ang * 0.15915494309189533577; rev -= rint(rev); const float rv = (float)rev;
          ct[i] = __builtin_amdgcn_cosf(rv); st[i] = __builtin_amdgcn_sinf(rv); } }
    wt_convert(P, shm, 0, 640);
}

__device__ __forceinline__ void bf8_acc(float (&s)[8], const u32x4 v, float sg) {
    s[0] += sg * bflo(v.x); s[1] += sg * bfhi(v.x); s[2] += sg * bflo(v.y); s[3] += sg * bfhi(v.y); s[4] += sg * bflo(v.z); s[5] += sg * bfhi(v.z); s[6] += sg * bflo(v.w); s[7] += sg * bfhi(v.w);
}
__device__ void ph_pool_diff(const Params& P) {
    const bf16_t* __restrict__ z = (const bf16_t*)(P.ws + OFF_Z); bf16_t* __restrict__ diff = (bf16_t*)(P.ws + OFF_DIFF);
    for (int it = blockIdx.x * 512 + threadIdx.x; it < 1024 * 128; it += gridDim.x * 512) {
        const int strip = it >> 7, oc = it & 127; const int R0 = strip * 16, s0 = R0 & (SEQ - 1); const int w = 2 << (oc >> 5);
        const bf16_t* zc = z + 8 * oc;
        float s[8];
#pragma unroll
        for (int i = 0; i < 8; ++i) s[i] = 0.f;
        if (s0 > 0) {
            u32x4 pv[16];
#pragma unroll
            for (int d = 1; d <= 16; ++d) pv[d - 1] = (d <= w) ? *(const u32x4*)(zc + (size_t)(R0 - d) * INC) : (u32x4){0u, 0u, 0u, 0u};
#pragma unroll
            for (int d = 1; d <= 16; ++d) bf8_acc(s, pv[d - 1], 1.0f);
        }
#pragma unroll
        for (int half = 0; half < 2; ++half) {
            u32x4 cu[8], od[8];
#pragma unroll
            for (int r = 0; r < 8; ++r) { const int rr = half * 8 + r; cu[r] = *(const u32x4*)(zc + (size_t)(R0 + rr) * INC);
                od[r] = (s0 + rr - w >= 0) ? *(const u32x4*)(zc + (size_t)(R0 + rr - w) * INC) : (u32x4){0u, 0u, 0u, 0u}; }
#pragma unroll
            for (int r = 0; r < 8; ++r) {
                const int rr = half * 8 + r, t = s0 + rr;
                bf8_acc(s, cu[r], 1.0f); bf8_acc(s, od[r], -1.0f);
                const float inv = 1.0f / (float)(t + 1 < w ? t + 1 : w);
                const u32x4 v = cu[r];
                u32x4 ow; ow.x = cvt_pk_bf16(s[0] * inv - bflo(v.x), s[1] * inv - bfhi(v.x)); ow.y = cvt_pk_bf16(s[2] * inv - bflo(v.y), s[3] * inv - bfhi(v.y));
                ow.z = cvt_pk_bf16(s[4] * inv - bflo(v.z), s[5] * inv - bfhi(v.z)); ow.w = cvt_pk_bf16(s[6] * inv - bflo(v.w), s[7] * inv - bfhi(v.w));
                *(u32x4*)(diff + (size_t)(R0 + rr) * 1024 + 8 * oc) = ow;
            }
        }
    }
}

constexpr int LP = 144;
struct KRaw { u32x4 a, c; f32x4 c0, c1, s0, s1; };
__device__ __forceinline__ void k_load(const bf16_t* z, const float* cosT, const float* sinT, int b, int h, int n, int it, KRaw& r) {
    const int j = it >> 3, o = it & 7, pos = n * 128 + j; const size_t t = (size_t)b * SEQ + pos;
    const bf16_t* kp = z + t * INC + 2048 + h * 128 + 8 * o;
    r.a = *(const u32x4*)kp; r.c = *(const u32x4*)(kp + 64);
    r.c0 = *(const f32x4*)(cosT + pos * 64 + 8 * o); r.c1 = *(const f32x4*)(cosT + pos * 64 + 8 * o + 4);
    r.s0 = *(const f32x4*)(sinT + pos * 64 + 8 * o); r.s1 = *(const f32x4*)(sinT + pos * 64 + 8 * o + 4);
}
template <bool TR, bool ZETA = TR> __device__ __forceinline__ void k_put(const KRaw& r, int it, float log2g, bf16_t* dst) {
    const int j = it >> 3, o = it & 7;
    const float sc = 0.08838834764831845f * (ZETA ? exp2f((float)(127 - j) * log2g) : 1.0f);
    const float x1[8] = {bflo(r.a.x), bfhi(r.a.x), bflo(r.a.y), bfhi(r.a.y), bflo(r.a.z), bfhi(r.a.z), bflo(r.a.w), bfhi(r.a.w)};
    const float x2[8] = {bflo(r.c.x), bfhi(r.c.x), bflo(r.c.y), bfhi(r.c.y), bflo(r.c.z), bfhi(r.c.z), bflo(r.c.w), bfhi(r.c.w)};
    const float cc[8] = {r.c0[0], r.c0[1], r.c0[2], r.c0[3], r.c1[0], r.c1[1], r.c1[2], r.c1[3]}, ss[8] = {r.s0[0], r.s0[1], r.s0[2], r.s0[3], r.s1[0], r.s1[1], r.s1[2], r.s1[3]};
    float o1[8], o2[8];
#pragma unroll
    for (int i = 0; i < 8; ++i) { o1[i] = (x1[i] * cc[i] - x2[i] * ss[i]) * sc; o2[i] = (x2[i] * cc[i] + x1[i] * ss[i]) * sc; }
    if (TR) {
#pragma unroll
        for (int i = 0; i < 8; ++i) { const unsigned pk = cvt_pk_bf16(o1[i], o2[i]); dst[(8 * o + i) * LP + j] = (bf16_t)(pk & 0xffffu); dst[(64 + 8 * o + i) * LP + j] = (bf16_t)(pk >> 16); }
    } else {
        u32x4 w1, w2; w1.x = cvt_pk_bf16(o1[0], o1[1]); w1.y = cvt_pk_bf16(o1[2], o1[3]); w1.z = cvt_pk_bf16(o1[4], o1[5]); w1.w = cvt_pk_bf16(o1[6], o1[7]);
        w2.x = cvt_pk_bf16(o2[0], o2[1]); w2.y = cvt_pk_bf16(o2[2], o2[3]); w2.z = cvt_pk_bf16(o2[4], o2[5]); w2.w = cvt_pk_bf16(o2[6], o2[7]);
        *(u32x4*)(dst + j * LP + 8 * o) = w1; *(u32x4*)(dst + j * LP + 64 + 8 * o) = w2;
    }
}
__device__ __forceinline__ u32x4 v_load(const bf16_t* z, int b, int h, int n, int it) {
    const int j = it >> 4, o = it & 15; const size_t t = (size_t)b * SEQ + n * 128 + j;
    return *(const u32x4*)(z + t * INC + 3072 + h * 128 + 8 * o);
}
__device__ __forceinline__ void v_put(const u32x4 v, int it, bf16_t* dst) {
    const int j = it >> 4, o = it & 15; const unsigned w[4] = {v.x, v.y, v.z, v.w};
#pragma unroll
    for (int i = 0; i < 4; ++i) { dst[(8 * o + 2 * i) * LP + j] = (bf16_t)(w[i] & 0xffffu); dst[(8 * o + 2 * i + 1) * LP + j] = (bf16_t)(w[i] >> 16); }
}

__device__ __forceinline__ void v_put_nat(const u32x4 v, int it, bf16_t* dst) { *(u32x4*)(dst + (it >> 4) * LP + (it & 15) * 8) = v; }
#define TRD(i, off) "ds_read_b64_tr_b16 %" #i ", %16 offset:" off "\n\t"
#define TR16(R, ADDR, S2) asm volatile( \
    TRD(0, "0") TRD(1, S2) TRD(2, "32") TRD(3, "32+" S2) TRD(4, "64") TRD(5, "64+" S2) TRD(6, "96") TRD(7, "96+" S2) \
    TRD(8, "128") TRD(9, "128+" S2) TRD(10, "160") TRD(11, "160+" S2) TRD(12, "192") TRD(13, "192+" S2) TRD(14, "224") TRD(15, "224+" S2) \
    "s_waitcnt lgkmcnt(0)" \
    : "=&v"(R[0][0]), "=&v"(R[0][1]), "=&v"(R[1][0]), "=&v"(R[1][1]), "=&v"(R[2][0]), "=&v"(R[2][1]), "=&v"(R[3][0]), "=&v"(R[3][1]), \
      "=&v"(R[4][0]), "=&v"(R[4][1]), "=&v"(R[5][0]), "=&v"(R[5][1]), "=&v"(R[6][0]), "=&v"(R[6][1]), "=&v"(R[7][0]), "=&v"(R[7][1]) \
    : "v"(ADDR) : "memory")
__device__ __forceinline__ bf16x8 cat8(const u32x2 lo, const u32x2 hi) { u32x4 w; w.x = lo.x; w.y = lo.y; w.z = hi.x; w.w = hi.y; return __builtin_bit_cast(bf16x8, w); }

__device__ void ph_ret_kv(const Params& P, unsigned char* shm) {
    const bf16_t* z = (const bf16_t*)(P.ws + OFF_Z); const float* cosT = (const float*)(P.ws + OFF_COS); const float* sinT = (const float*)(P.ws + OFF_SIN);
    bf16_t* kvT = (bf16_t*)(P.ws + OFF_KVT);
    bf16_t* kn = (bf16_t*)shm; bf16_t* vn = kn + 128 * LP;
    const int tid = threadIdx.x, w = __builtin_amdgcn_readfirstlane(tid >> 6), lane = tid & 63, fr = lane & 15, fq = lane >> 4;
    const unsigned lbase = (unsigned)(size_t)(LAS unsigned char*)shm;
    const unsigned tro = (unsigned)(((8 * fq + (fr >> 2)) * LP + 4 * (fr & 3)) * 2);
    KRaw kr[2]; u32x4 vr[4];
    int ui = blockIdx.x;
    if (ui < 960) { const int bh = ui / 15, n = ui - bh * 15, h = bh & 7, b = bh >> 3;
#pragma unroll
        for (int i = 0; i < 4; ++i) vr[i] = v_load(z, b, h, n, tid + 512 * i);
#pragma unroll
        for (int i = 0; i < 2; ++i) k_load(z, cosT, sinT, b, h, n, tid + 512 * i, kr[i]); }
    for (; ui < 960; ui += gridDim.x) {
        const int bh = ui / 15, n = ui - bh * 15, h = bh & 7, unit = bh * 16 + n;
#pragma unroll
        for (int i = 0; i < 4; ++i) v_put_nat(vr[i], tid + 512 * i, vn);
#pragma unroll
        for (int i = 0; i < 2; ++i) k_put<false, true>(kr[i], tid + 512 * i, P.log2g[h], kn);
        __syncthreads();
        { const int un = ui + gridDim.x;
          if (un < 960) { const int bh2 = un / 15, n2 = un - bh2 * 15, h2 = bh2 & 7, b2 = bh2 >> 3;
#pragma unroll
              for (int i = 0; i < 4; ++i) vr[i] = v_load(z, b2, h2, n2, tid + 512 * i);
#pragma unroll
              for (int i = 0; i < 2; ++i) k_load(z, cosT, sinT, b2, h2, n2, tid + 512 * i, kr[i]); } }
        f32x4 acc[8];
#pragma unroll
        for (int eb = 0; eb < 8; ++eb) acc[eb] = (f32x4){0.f, 0.f, 0.f, 0.f};
#pragma unroll
        for (int ks = 0; ks < 4; ++ks) {
            const unsigned ka = lbase + tro + (unsigned)(ks * 32 * LP * 2 + 16 * w * 2);
            u32x2 a0, a1;
            asm volatile("ds_read_b64_tr_b16 %0, %2\n\tds_read_b64_tr_b16 %1, %2 offset:1152\n\ts_waitcnt lgkmcnt(0)" : "=&v"(a0), "=&v"(a1) : "v"(ka) : "memory");
            const bf16x8 a = cat8(a0, a1);
            const unsigned va = lbase + (unsigned)(128 * LP * 2) + tro + (unsigned)(ks * 32 * LP * 2);
            u32x2 R[8][2];
            TR16(R, va, "1152");
#pragma unroll
            for (int eb = 0; eb < 8; ++eb) acc[eb] = __builtin_amdgcn_mfma_f32_16x16x32_bf16(a, cat8(R[eb][0], R[eb][1]), acc[eb], 0, 0, 0);
        }
        bf16_t* dst = kvT + (size_t)unit * 16384;
#pragma unroll
        for (int eb = 0; eb < 8; ++eb) { u32x2 kw; kw.x = cvt_pk_bf16(acc[eb][0], acc[eb][1]); kw.y = cvt_pk_bf16(acc[eb][2], acc[eb][3]); *(u32x2*)(dst + (16 * eb + fr) * 128 + 16 * w + 4 * fq) = kw; }
        __syncthreads();
    }
}
__device__ void ph_ret_scan(const Params& P) {
    const bf16_t* kvT = (const bf16_t*)(P.ws + OFF_KVT); bf16_t* RT = (bf16_t*)(P.ws + OFF_RT);
    for (int it = blockIdx.x * 512 + threadIdx.x; it < 64 * 4096; it += gridDim.x * 512) {
        const int bh = it >> 12, q4 = it & 4095; const float gc = exp2f(128.0f * P.log2g[bh & 7]);
        const size_t o0 = ((size_t)(bh * 16)) * 16384 + 4 * q4;
        u32x2 kv[15];
#pragma unroll
        for (int n = 0; n < 15; ++n) kv[n] = *(const u32x2*)(kvT + o0 + (size_t)n * 16384);
        f32x4 R = {0.f, 0.f, 0.f, 0.f};
#pragma unroll
        for (int n = 0; n < 16; ++n) {
            u32x2 w; w.x = cvt_pk_bf16(R[0], R[1]); w.y = cvt_pk_bf16(R[2], R[3]); *(u32x2*)(RT + o0 + (size_t)n * 16384) = w;
            if (n < 15) R = R * gc + (f32x4){bflo(kv[n].x), bfhi(kv[n].x), bflo(kv[n].y), bfhi(kv[n].y)};
        }
    }
}
__device__ void ph_ret_out(const Params& P, unsigned char* shm) {
    const bf16_t* z = (const bf16_t*)(P.ws + OFF_Z); const float* cosT = (const float*)(P.ws + OFF_COS); const float* sinT = (const float*)(P.ws + OFF_SIN);
    const bf16_t* RT = (const bf16_t*)(P.ws + OFF_RT); bf16_t* mix = (bf16_t*)(P.ws + OFF_MIX);
    bf16_t* kn = (bf16_t*)shm; bf16_t* vn = kn + 128 * LP; bf16_t* rts = vn + 128 * LP;
    const unsigned lbase = (unsigned)(size_t)(LAS unsigned char*)shm;
    const int tid = threadIdx.x, w = __builtin_amdgcn_readfirstlane(tid >> 6), lane = tid & 63, fr = lane & 15, fq = lane >> 4;
    for (int unit = blockIdx.x; unit < 1024; unit += gridDim.x) {
        const int n = unit & 15, h = (unit >> 4) & 7, b = unit >> 7; const float log2g = P.log2g[h];
        const int il = 16 * w + fr, pos = n * 128 + il; const size_t t = (size_t)b * SEQ + pos;
        KRaw kr[2]; u32x4 vr[4], rr[4]; KRaw qr[2]; u32x2 gg[8];
#pragma unroll
        for (int i = 0; i < 4; ++i) vr[i] = v_load(z, b, h, n, tid + 512 * i);
#pragma unroll
        for (int i = 0; i < 2; ++i) k_load(z, cosT, sinT, b, h, n, tid + 512 * i, kr[i]);
        if (n > 0) {
#pragma unroll
            for (int i = 0; i < 4; ++i) { const int it = tid + 512 * i; rr[i] = *(const u32x4*)(RT + (size_t)unit * 16384 + (it >> 4) * 128 + (it & 15) * 8); }
        }
#pragma unroll
        for (int kp = 0; kp < 2; ++kp) {
            const int d0 = 8 * fq + 32 * kp; const bf16_t* qp = z + t * INC + 1024 + h * 128 + d0;
            qr[kp].a = *(const u32x4*)qp; qr[kp].c = *(const u32x4*)(qp + 64);
            qr[kp].c0 = *(const f32x4*)(cosT + pos * 64 + d0); qr[kp].c1 = *(const f32x4*)(cosT + pos * 64 + d0 + 4);
            qr[kp].s0 = *(const f32x4*)(sinT + pos * 64 + d0); qr[kp].s1 = *(const f32x4*)(sinT + pos * 64 + d0 + 4);
        }
#pragma unroll
        for (int eb = 0; eb < 8; ++eb) gg[eb] = *(const u32x2*)(z + t * INC + 4096 + h * 128 + 16 * eb + 4 * fq);
        f32x4 gwv[8];
#pragma unroll
        for (int eb = 0; eb < 8; ++eb) gwv[eb] = *(const f32x4*)(P.ret_gn_w + h * 128 + 16 * eb + 4 * fq);
        __builtin_amdgcn_sched_barrier(0);
#pragma unroll
        for (int i = 0; i < 4; ++i) v_put_nat(vr[i], tid + 512 * i, vn);
#pragma unroll
        for (int i = 0; i < 2; ++i) k_put<false>(kr[i], tid + 512 * i, log2g, kn);
        if (n > 0) {
#pragma unroll
            for (int i = 0; i < 4; ++i) { const int it = tid + 512 * i; *(u32x4*)(rts + (it >> 4) * LP + (it & 15) * 8) = rr[i]; }
        }
        bf16x8 qf[4];
#pragma unroll
        for (int kp = 0; kp < 2; ++kp) {
            const u32x4 a = qr[kp].a, c = qr[kp].c;
            const float x1[8] = {bflo(a.x), bfhi(a.x), bflo(a.y), bfhi(a.y), bflo(a.z), bfhi(a.z), bflo(a.w), bfhi(a.w)};
            const float x2[8] = {bflo(c.x), bfhi(c.x), bflo(c.y), bfhi(c.y), bflo(c.z), bfhi(c.z), bflo(c.w), bfhi(c.w)};
            const float cc[8] = {qr[kp].c0[0], qr[kp].c0[1], qr[kp].c0[2], qr[kp].c0[3], qr[kp].c1[0], qr[kp].c1[1], qr[kp].c1[2], qr[kp].c1[3]};
            const float ss[8] = {qr[kp].s0[0], qr[kp].s0[1], qr[kp].s0[2], qr[kp].s0[3], qr[kp].s1[0], qr[kp].s1[1], qr[kp].s1[2], qr[kp].s1[3]};
            float o1[8], o2[8];
#pragma unroll
            for (int i = 0; i < 8; ++i) { o1[i] = x1[i] * cc[i] - x2[i] * ss[i]; o2[i] = x2[i] * cc[i] + x1[i] * ss[i]; }
            u32x4 w1, w2; w1.x = cvt_pk_bf16(o1[0], o1[1]); w1.y = cvt_pk_bf16(o1[2], o1[3]); w1.z = cvt_pk_bf16(o1[4], o1[5]); w1.w = cvt_pk_bf16(o1[6], o1[7]);
            w2.x = cvt_pk_bf16(o2[0], o2[1]); w2.y = cvt_pk_bf16(o2[2], o2[3]); w2.z = cvt_pk_bf16(o2[4], o2[5]); w2.w = cvt_pk_bf16(o2[6], o2[7]);
            qf[kp] = __builtin_bit_cast(bf16x8, w1); qf[kp + 2] = __builtin_bit_cast(bf16x8, w2);
        }
        __syncthreads();
        f32x4 acc[8];
#pragma unroll
        for (int eb = 0; eb < 8; ++eb) acc[eb] = (f32x4){0.f, 0.f, 0.f, 0.f};
        if (n > 0) {
#pragma unroll
            for (int ks = 0; ks < 4; ++ks)
#pragma unroll
                for (int eb = 0; eb < 8; ++eb) { const bf16x8 a = *(const bf16x8*)(rts + (16 * eb + fr) * LP + 32 * ks + 8 * fq); acc[eb] = __builtin_amdgcn_mfma_f32_16x16x32_bf16(a, qf[ks], acc[eb], 0, 0, 0); }
            const float xi = exp2f((float)(il + 1) * log2g);
#pragma unroll
            for (int eb = 0; eb < 8; ++eb) acc[eb] *= xi;
        }
        for (int s = 0; s <= (w >> 1); ++s) {
            const int jb0 = 2 * s, jb1 = 2 * s + 1;
            f32x4 st0 = {0.f, 0.f, 0.f, 0.f}, st1 = {0.f, 0.f, 0.f, 0.f};
#pragma unroll
            for (int ks = 0; ks < 4; ++ks) { const bf16x8 a0 = *(const bf16x8*)(kn + (16 * jb0 + fr) * LP + 32 * ks + 8 * fq); st0 = __builtin_amdgcn_mfma_f32_16x16x32_bf16(a0, qf[ks], st0, 0, 0, 0); }
            if (jb1 <= w) {
#pragma unroll
                for (int ks = 0; ks < 4; ++ks) { const bf16x8 a1 = *(const bf16x8*)(kn + (16 * jb1 + fr) * LP + 32 * ks + 8 * fq); st1 = __builtin_amdgcn_mfma_f32_16x16x32_bf16(a1, qf[ks], st1, 0, 0, 0); }
            }
#pragma unroll
            for (int r = 0; r < 4; ++r) {
                const int d0 = il - (16 * jb0 + 4 * fq + r), d1 = il - (16 * jb1 + 4 * fq + r);
                st0[r] = d0 >= 0 ? st0[r] * exp2f((float)d0 * log2g) : 0.f;
                st1[r] = d1 >= 0 ? st1[r] * exp2f((float)d1 * log2g) : 0.f;
            }
            u32x4 sw; sw.x = cvt_pk_bf16(st0[0], st0[1]); sw.y = cvt_pk_bf16(st0[2], st0[3]); sw.z = cvt_pk_bf16(st1[0], st1[1]); sw.w = cvt_pk_bf16(st1[2], st1[3]);
            const bf16x8 sb = __builtin_bit_cast(bf16x8, sw);
            const unsigned va = lbase + (unsigned)(128 * LP * 2) + (unsigned)(((32 * s + 4 * fq + (fr >> 2)) * LP + 4 * (fr & 3)) * 2);
            u32x2 R[8][2];
            TR16(R, va, "4608");
#pragma unroll
            for (int eb = 0; eb < 8; ++eb) acc[eb] = __builtin_amdgcn_mfma_f32_16x16x32_bf16(cat8(R[eb][0], R[eb][1]), sb, acc[eb], 0, 0, 0);
        }
        float sm = 0.f;
#pragma unroll
        for (int eb = 0; eb < 8; ++eb) sm += (acc[eb][0] + acc[eb][1]) + (acc[eb][2] + acc[eb][3]);
        sm += __shfl_xor(sm, 16); sm += __shfl_xor(sm, 32);
        const float mu = sm * (1.0f / 128.0f);
        float qv = 0.f;
#pragma unroll
        for (int eb = 0; eb < 8; ++eb) { const f32x4 d = acc[eb] - mu; qv += (d[0] * d[0] + d[1] * d[1]) + (d[2] * d[2] + d[3] * d[3]); }
        qv += __shfl_xor(qv, 16); qv += __shfl_xor(qv, 32);
        const float rstd = rsqrtf(qv * (1.0f / 128.0f) + GN_EPS);
#pragma unroll
        for (int eb = 0; eb < 8; ++eb) {
            const int e0 = 16 * eb + 4 * fq;
            const f32x4 gw = gwv[eb];
            const float gv[4] = {bflo(gg[eb].x), bfhi(gg[eb].x), bflo(gg[eb].y), bfhi(gg[eb].y)};
            float y[4];
#pragma unroll
            for (int r = 0; r < 4; ++r) y[r] = (acc[eb][r] - mu) * rstd * gw[r] * gv[r] * sigmoidf_(gv[r]);
            u32x2 ow; ow.x = cvt_pk_bf16(y[0], y[1]); ow.y = cvt_pk_bf16(y[2], y[3]);
            *(u32x2*)(mix + t * DM + 1024 + h * 128 + e0) = ow;
        }
        __syncthreads();
    }
}
__device__ void ph_fixup(const Params& P) {
    const float* edge = (const float*)(P.ws + OFF_EDGE); bf16_t* act = (bf16_t*)(P.ws + OFF_ACT);
    for (int it = blockIdx.x * 512 + threadIdx.x; it < 256 * 1376; it += gridDim.x * 512) {
        const int fq4 = it % 1376, run = it / 1376;
        if ((run & 31) == 0) continue;
        const int f = 4 * fq4, pn = f >> 7, cf = f & 127, cg_ = pn * 256 + cf, cv_ = cg_ + 128;
        const float* e1 = edge + (size_t)run * 4 * UPC; const float* e0 = edge + (size_t)(run - 1) * 4 * UPC;
        const f32x4 Ga = *(const f32x4*)(e0 + 2 * UPC + cg_), Gb = *(const f32x4*)(e0 + 3 * UPC + cg_), Gc = *(const f32x4*)(e1 + cg_), Gd = *(const f32x4*)(e1 + UPC + cg_);
        const f32x4 Va = *(const f32x4*)(e0 + 2 * UPC + cv_), Vb = *(const f32x4*)(e0 + 3 * UPC + cv_), Vc = *(const f32x4*)(e1 + cv_), Vd = *(const f32x4*)(e1 + UPC + cv_);
        const float* cw = P.conv_w; const float* cb = P.conv_b;
        const f32x4 w0g = *(const f32x4*)(cw + f), w1g = *(const f32x4*)(cw + UPC + f), w2g = *(const f32x4*)(cw + 2 * UPC + f), bg = *(const f32x4*)(cb + f);
        const f32x4 w0v = *(const f32x4*)(cw + DFF + f), w1v = *(const f32x4*)(cw + UPC + DFF + f), w2v = *(const f32x4*)(cw + 2 * UPC + DFF + f), bv = *(const f32x4*)(cb + DFF + f);
        const f32x4 gate0 = bg + w2g * Gc + w1g * Gb + w0g * Ga, val0 = bv + w2v * Vc + w1v * Vb + w0v * Va;
        const f32x4 gate1 = bg + w2g * Gd + w1g * Gc + w0g * Gb, val1 = bv + w2v * Vd + w1v * Vc + w0v * Vb;
        f32x4 a0, a1;
#pragma unroll
        for (int j = 0; j < 4; ++j) { a0[j] = gate0[j] * sigmoidf_(gate0[j]) * val0[j]; a1[j] = gate1[j] * sigmoidf_(gate1[j]) * val1[j]; }
        u32x2 w0, w1; w0.x = cvt_pk_bf16(a0[0], a0[1]); w0.y = cvt_pk_bf16(a0[2], a0[3]); w1.x = cvt_pk_bf16(a1[0], a1[1]); w1.y = cvt_pk_bf16(a1[2], a1[3]);
        *(u32x2*)(act + (size_t)(run * 64) * DFF + f) = w0; *(u32x2*)(act + (size_t)(run * 64 + 1) * DFF + f) = w1;
    }
}
__device__ void ph_final(const Params& P) {
    const int lane = threadIdx.x & 63, gw = blockIdx.x * 8 + (threadIdx.x >> 6), nw = gridDim.x * 8;
    const float* ss4 = (const float*)(P.ws + OFF_SUMSQ) + 3 * NTOK; const bf16_t* h3b = (const bf16_t*)(P.ws + OFF_H3B);
    const f32x4* fw = (const f32x4*)P.final_norm_w;
    for (int row = gw; row < NTOK; row += 2 * nw) {
        const int row2 = row + nw; const bool has2 = row2 < NTOK;
        const u32x4* hi = (const u32x4*)(h3b + (size_t)row * DM); const u32x4* hj = (const u32x4*)(h3b + (size_t)(has2 ? row2 : row) * DM);
        u32x4 ha[4], hb[4];
#pragma unroll
        for (int i = 0; i < 4; ++i) { ha[i] = hi[i * 64 + lane]; hb[i] = hj[i * 64 + lane]; }
        const float rs = rsqrtf(ss4[row] * (1.0f / 2048.0f) + NORM_EPS), rs2 = rsqrtf(ss4[has2 ? row2 : row] * (1.0f / 2048.0f) + NORM_EPS);
        f32x4* o = (f32x4*)(P.out + (size_t)row * DM); f32x4* o2 = (f32x4*)(P.out + (size_t)row2 * DM);
#pragma unroll
        for (int i = 0; i < 4; ++i) { const int c = (i * 64 + lane) * 2; const f32x4 w0 = fw[c], w1 = fw[c + 1];
            o[c] = bf4lo(ha[i]) * rs * w0; o[c + 1] = bf4hi(ha[i]) * rs * w1;
            if (has2) { o2[c] = bf4lo(hb[i]) * rs2 * w0; o2[c + 1] = bf4hi(hb[i]) * rs2 * w1; } }
    }
}

#define XB_TMO      128
#define XB_XCNT(j)  (256  + 64 * (j))
#define XB_XSUB(j)  (1280 + 64 * (j))
#define XB_XGEN(j)  (2304 + 64 * (j))
#define XB_TOP      3328
#define XB_TOPGEN   3392
#define XCD_BAR_WORDS 3456
#define XB_SPIN_CAP (1u << 18)
__device__ __forceinline__ unsigned xb_ld(unsigned* p)              { return __hip_atomic_load(p, __ATOMIC_RELAXED, __HIP_MEMORY_SCOPE_AGENT); }
__device__ __forceinline__ unsigned xb_add(unsigned* p, unsigned v) { return __hip_atomic_fetch_add(p, v, __ATOMIC_RELAXED, __HIP_MEMORY_SCOPE_AGENT); }
__device__ __forceinline__ unsigned xb_xcc_id() { return (unsigned)__builtin_amdgcn_s_getreg((3 << 11) | 20) & 0xFu; }
#define XB_SPIN(cond, bar) do { unsigned _sp = 0; while (cond) { __builtin_amdgcn_s_sleep(1); \
    if ((++_sp & 255u) == 0u) { if (xb_ld(&(bar)[XB_TMO])) break; if (_sp > XB_SPIN_CAP) { atomicAdd(&(bar)[XB_TMO], 1u); break; } } } } while (0)
struct XcdBarrier { unsigned* bar; unsigned x; volatile LAS unsigned* st; };
__device__ __forceinline__ XcdBarrier xcd_barrier_post(unsigned* bar, volatile LAS unsigned* st) {
    XcdBarrier b; b.bar = bar; b.x = xb_xcc_id(); b.st = st;
    if (threadIdx.x == 0) (void)xb_add(&bar[XB_XCNT(b.x)], 1u);
    return b;
}
__device__ __forceinline__ void xcd_barrier_complete(unsigned* bar, unsigned x, unsigned& nloc, unsigned& nx) {
    const unsigned G = gridDim.x * gridDim.y * gridDim.z;
    unsigned sum, cnt, mine, sp = 0u;
    for (;;) {
        sum = 0u; cnt = 0u; mine = 0u;
#pragma unroll
        for (unsigned j = 0; j < 16; ++j) { const unsigned c = xb_ld(&bar[XB_XCNT(j)]); sum += c; cnt += (c > 0u) ? 1u : 0u; mine = (j == x) ? c : mine; }
        if (sum == G) break;
        __builtin_amdgcn_s_sleep(1);
        if ((++sp & 255u) == 0u) { if (xb_ld(&bar[XB_TMO])) break; if (sp > XB_SPIN_CAP) { atomicAdd(&bar[XB_TMO], 1u); break; } }
    }
    nloc = mine > 0u ? mine : 1u; nx = cnt > 0u ? cnt : 1u;
}
__device__ __forceinline__ void xcd_barrier(const XcdBarrier& b) {
    asm volatile("s_waitcnt vmcnt(0)" ::: "memory");
    __syncthreads();
    if (threadIdx.x == 0) {
        unsigned* bar = b.bar;
        __builtin_amdgcn_s_waitcnt(0);
        unsigned nloc = b.st[0], nx = b.st[1];
        if (nloc == 0u) { xcd_barrier_complete(bar, b.x, nloc, nx); b.st[0] = nloc; b.st[1] = nx; }
        const unsigned old = xb_add(&bar[XB_XSUB(b.x)], 1u);
        const unsigned gen = old / nloc;
        if (old + 1u == (gen + 1u) * nloc) {
            __builtin_amdgcn_fence(__ATOMIC_RELEASE, "agent");
            asm volatile("s_waitcnt vmcnt(0)" ::: "memory");
            const unsigned og = xb_add(&bar[XB_TOP], 1u);
            const unsigned tg = og / nx;
            if (og + 1u == (tg + 1u) * nx) xb_add(&bar[XB_TOPGEN], 1u);
            else XB_SPIN(xb_ld(&bar[XB_TOPGEN]) == tg, bar);
            __builtin_amdgcn_fence(__ATOMIC_ACQUIRE, "agent");
            xb_add(&bar[XB_XGEN(b.x)], 1u);
            asm volatile("s_waitcnt vmcnt(0)" ::: "memory");
        } else {
            XB_SPIN(xb_ld(&bar[XB_XGEN(b.x)]) == gen, bar);
            __builtin_amdgcn_fence(__ATOMIC_ACQUIRE, "agent");
            asm volatile("s_waitcnt vmcnt(0)" ::: "memory");
        }
    }
    __syncthreads();
}

__global__ void __launch_bounds__(512, 2) fwd_megakernel(const Params P) {
    extern __shared__ __attribute__((aligned(16))) unsigned char shm[];
    __shared__ uint4 xb_words;
    LAS unsigned char* lds = (LAS unsigned char*)shm;
    unsigned char* ws = P.ws;
    unsigned* xbar = (unsigned*)(ws + OFF_BAR);
    if (threadIdx.x == 0) xb_words = make_uint4(0u, 0u, 0u, 0u);
    __syncthreads();
    XcdBarrier xb = xcd_barrier_post(xbar, (volatile LAS unsigned*)&xb_words);
    float* ss = (float*)(ws + OFF_SUMSQ);
    pg8::StaticOrder S;
#define PH_ON(i) (P.ph_lo <= (i) && (i) < P.ph_hi)
#define PH_SYNC(i) if (P.ph_lo <= (i) && (i) + 1 < P.ph_hi) xcd_barrier(xb);
#if (PHMASK >> 0) & 1
    if (PH_ON(0)) ph_prologue(P, shm);
#endif
    PH_SYNC(0)
#if (PHMASK >> 1) & 1
    if (PH_ON(1)) { pg8::Gemm g{(const bf16_t*)(ws + OFF_XB), (const bf16_t*)(ws + OFF_WIN), NTOK, INC, DM, DM, DM, 0}; S.init(NTOK, INC, gridDim.x, blockIdx.x);
        EpiScaleBf16 E{(bf16_t*)(ws + OFF_Z), INC, ss, nullptr}; pg8::gemm_phase(lds, g, S, E); }
#endif
    PH_SYNC(1)
#if (PHMASK >> 2) & 1
    if (PH_ON(2)) { const bool first = (blockIdx.x >> 3) & 1;
        if (first) wt_convert(P, shm, 2016, 3264);
        ph_pool_diff(P); ph_ret_kv(P, shm);
        if (!first) wt_convert(P, shm, 2016, 3264); }
#endif
    PH_SYNC(2)
#if (PHMASK >> 3) & 1
    if (PH_ON(3)) { pg8::Gemm g{(const bf16_t*)(ws + OFF_DIFF), (const bf16_t*)(ws + OFF_POOLT), NTOK, 1024, 256, 1024, 256, 512}; S.init(NTOK, 1024, gridDim.x, blockIdx.x);
        EpiScaleBf16 E{(bf16_t*)(ws + OFF_MIX), DM, nullptr, P.pool_scale}; pg8::gemm_phase(lds, g, S, E); ph_ret_scan(P); }
#endif
    PH_SYNC(3)
#if (PHMASK >> 4) & 1
    if (PH_ON(4)) { const bool first = (blockIdx.x >> 3) & 1;
        if (first) wt_convert(P, shm, 640, 2016);
        ph_ret_out(P, shm);
        if (!first) wt_convert(P, shm, 640, 2016); }
#endif
    PH_SYNC(4)
#if (PHMASK >> 5) & 1
    if (PH_ON(5)) { pg8::Gemm g{(const bf16_t*)(ws + OFF_MIX), (const bf16_t*)(ws + OFF_WOUT), NTOK, DM, DM, DM, DM, 0}; S.init(NTOK, DM, gridDim.x, blockIdx.x);
        EpiRes<false> E{ws + OFF_XB, (bf16_t*)(ws + OFF_H1B), ss + NTOK}; pg8::gemm_phase(lds, g, S, E); }
#endif
    PH_SYNC(5)
#if (PHMASK >> 6) & 1
    if (PH_ON(6)) { pg8::Gemm g{(const bf16_t*)(ws + OFF_H1B), (const bf16_t*)(ws + OFF_WUP), NTOK, UPC, DM, DM, DM, 0}; S.init(NTOK, UPC, gridDim.x, blockIdx.x);
        EpiUp E{(bf16_t*)(ws + OFF_ACT), (float*)(ws + OFF_EDGE), ss + NTOK, P.conv_w, P.conv_b}; pg8::gemm_phase(lds, g, S, E); }
#endif
    PH_SYNC(6)
#if (PHMASK >> 7) & 1
    if (PH_ON(7)) ph_fixup(P);
#endif
    PH_SYNC(7)
#if (PHMASK >> 8) & 1
    if (PH_ON(8)) { pg8::Gemm g{(const bf16_t*)(ws + OFF_ACT), (const bf16_t*)(ws + OFF_WDOWN), NTOK, DM, DFF, DFF, DFF, 0}; S.init(NTOK, DM, gridDim.x, blockIdx.x);
        EpiRes<false> E{ws + OFF_H1B, (bf16_t*)(ws + OFF_H2B), ss + 2 * NTOK}; pg8::gemm_phase(lds, g, S, E); }
#endif
#if (PHMASK >> 11) & 1
    if (PH_ON(8)) { pg8::Gemm g2{(const bf16_t*)(ws + OFF_PB), (const bf16_t*)(ws + OFF_WPROJ), NTOK, DM, PLE, PLE, PLE, 0}; S.init(NTOK, DM, gridDim.x, blockIdx.x);
        EpiScaleBf16 E2{(bf16_t*)(ws + OFF_PROJ), DM, nullptr, nullptr}; pg8::gemm_phase(lds, g2, S, E2); }
#endif
    PH_SYNC(8)
#if (PHMASK >> 9) & 1
    if (PH_ON(9)) { pg8::Gemm g{(const bf16_t*)(ws + OFF_H2B), (const bf16_t*)(ws + OFF_WGATE), NTOK, DM, DM, DM, DM, 0}; S.init(NTOK, DM, gridDim.x, blockIdx.x);
        EpiGate E{(const bf16_t*)(ws + OFF_H2B), (bf16_t*)(ws + OFF_H3B), (const bf16_t*)(ws + OFF_PROJ), ss + 2 * NTOK, ss + 3 * NTOK}; pg8::gemm_phase(lds, g, S, E); }
#endif
    PH_SYNC(9)
#if (PHMASK >> 10) & 1
    if (PH_ON(10)) ph_final(P);
#endif
    if (P.ph_hi > 1000) cg::this_grid().sync();
}

constexpr int NPHASES = 11;

extern "C" void kernel_launch(void* const* d_in, const int* in_sizes, int n_in, void* d_out, int out_size, void* d_ws, size_t ws_size, hipStream_t stream) {
    (void)in_sizes; (void)n_in; (void)out_size; (void)ws_size;
    static int grid_blocks = 0;
    if (!grid_blocks) {
        (void)hipFuncSetAttribute((const void*)fwd_megakernel, hipFuncAttributeMaxDynamicSharedMemorySize, LDS_BYTES);
        int dev = 0, cus = 0, per_cu = 0;
        (void)hipGetDevice(&dev);
        (void)hipDeviceGetAttribute(&cus, hipDeviceAttributeMultiprocessorCount, dev);
        (void)hipOccupancyMaxActiveBlocksPerMultiprocessor(&per_cu, fwd_megakernel, 512, LDS_BYTES);
        if (per_cu < 1) per_cu = 1;
        if (per_cu > 1) per_cu = 1;
        grid_blocks = cus * per_cu;
    }
    Params P;
    memset(&P, 0, sizeof(P));
    P.x = (const float*)d_in[0]; P.p = (const float*)d_in[1]; P.norm1_w = (const float*)d_in[2]; P.w_in = (const float*)d_in[3];
    P.pool_w = (const float*)d_in[4]; P.pool_scale = (const float*)d_in[5]; P.ret_gn_w = (const float*)d_in[6]; P.w_out = (const float*)d_in[7];
    P.norm2_w = (const float*)d_in[8]; P.w_up = (const float*)d_in[9]; P.conv_w = (const float*)d_in[10]; P.conv_b = (const float*)d_in[11];
    P.w_down = (const float*)d_in[12]; P.norm3_w = (const float*)d_in[13]; P.ple_gate_w = (const float*)d_in[14]; P.ple_proj_w = (const float*)d_in[15];
    P.final_norm_w = (const float*)d_in[16];
    P.out = (float*)d_out; P.ws = (unsigned char*)d_ws;
    for (int i = 0; i < 64; ++i) { const float e = (float)(2 * i) / 128.0f; const float pw = powf(10000.0f, e); P.inv_freq[i] = 1.0f / pw; }
    for (int h = 0; h < 8; ++h) { const float gamma = 1.0f - exp2f(-5.0f - (float)h); P.log2g[h] = (float)std::log2((double)gamma); }
#if MK_SINGLE
    P.ph_lo = 0; P.ph_hi = NPHASES;
    void* args[] = {(void*)&P};
    (void)hipMemsetAsync((unsigned char*)d_ws + OFF_BAR, 0, XCD_BAR_WORDS * 4, stream);
    hipError_t e = hipLaunchCooperativeKernel((const void*)fwd_megakernel, dim3(grid_blocks), dim3(512), args, LDS_BYTES, stream);
    if (e != hipSuccess) fprintf(stderr, "cooperative launch failed: %s (grid %d)\n", hipGetErrorString(e), grid_blocks);
#else
    for (int ph = 0; ph < NPHASES; ++ph) {
        P.ph_lo = ph; P.ph_hi = ph + 1;
        hipLaunchKernelGGL(fwd_megakernel, dim3(grid_blocks), dim3(512), LDS_BYTES, stream, P);
    }
#endif
}
```

```cpp
#include <hip/hip_runtime.h>
#include <hip/hip_cooperative_groups.h>
#include <cmath>
#include <cstdio>
#include <cstring>
namespace cg = cooperative_groups;

#ifndef PHMASK
#define PHMASK 0xfff
#endif
#ifndef MK_SINGLE
#define MK_SINGLE 1
#endif

#define LAS __attribute__((address_space(3)))
typedef unsigned short bf16_t;
typedef short bf16x8 __attribute__((ext_vector_type(8)));
typedef float f32x4 __attribute__((ext_vector_type(4)));
typedef unsigned u32x4 __attribute__((ext_vector_type(4)));
typedef unsigned u32x2 __attribute__((ext_vector_type(2)));

constexpr int NTOK = 16384, DM = 2048, SEQ = 2048, INC = 5120, DFF = 5504, UPC = 11008, PLE = 256;
constexpr float NORM_EPS = 1e-6f, GN_EPS = 1e-5f;
constexpr size_t MiB = 1048576;
constexpr size_t OFF_WIN = 0, OFF_WPROJ = 20 * MiB, OFF_POOLT = 21 * MiB, OFF_WOUT = 22 * MiB, OFF_WUP = 30 * MiB,
                 OFF_WDOWN = 73 * MiB, OFF_WGATE = 95 * MiB, OFF_SUMSQ = 103 * MiB, OFF_COS = 103 * MiB + 262144,
                 OFF_SIN = OFF_COS + 524288, OFF_BAR = 104 * MiB + 524288, OFF_PB = 105 * MiB,
                 OFF_XB = 113 * MiB, OFF_Z = 177 * MiB, OFF_DIFF = 337 * MiB, OFF_KVT = 369 * MiB  , OFF_RT = 401 * MiB,
                 OFF_MIX = 433 * MiB, OFF_H1B = 177 * MiB, OFF_ACT = 241 * MiB, OFF_EDGE = 413 * MiB,
                 OFF_H2B = 113 * MiB, OFF_PROJ = 448 * MiB, OFF_H3B = 177 * MiB;
constexpr int LDS_BYTES = 131072 + 16384;
constexpr int EPI_LDS = 131072;

struct Params {
    const float *x, *p, *norm1_w, *w_in, *pool_w, *pool_scale, *ret_gn_w, *w_out, *norm2_w, *w_up, *conv_w, *conv_b, *w_down,
        *norm3_w, *ple_gate_w, *ple_proj_w, *final_norm_w;
    float* out;
    unsigned char* ws;
    float inv_freq[64];
    float log2g[8];
    int ph_lo, ph_hi;
};

typedef __bf16 bf16x2_t __attribute__((ext_vector_type(2)));
typedef float f32x2_t __attribute__((ext_vector_type(2)));
__device__ __forceinline__ unsigned cvt_pk_bf16(float lo, float hi) { const f32x2_t v = {lo, hi}; return __builtin_bit_cast(unsigned, __builtin_convertvector(v, bf16x2_t)); }
__device__ __forceinline__ float bflo(unsigned w) { return __uint_as_float(w << 16); }
__device__ __forceinline__ float bfhi(unsigned w) { return __uint_as_float(w & 0xffff0000u); }
__device__ __forceinline__ float sigmoidf_(float v) { return __builtin_amdgcn_rcpf(1.0f + __expf(-v)); }
template <int CTRL> __device__ __forceinline__ float dpp_f(float v) { return __builtin_bit_cast(float, __builtin_amdgcn_update_dpp(0, __builtin_bit_cast(int, v), CTRL, 0xf, 0xf, true)); }
template <int CTRL> __device__ __forceinline__ float dpp_o(float old, float v) { return __builtin_bit_cast(float, __builtin_amdgcn_update_dpp(__builtin_bit_cast(int, old), __builtin_bit_cast(int, v), CTRL, 0xf, 0xf, false)); }
__device__ __forceinline__ float wave_sum(float s) {
    s += __shfl_xor(s, 32); s += __shfl_xor(s, 16); s += __shfl_xor(s, 8); s += __shfl_xor(s, 4); s += __shfl_xor(s, 2); s += __shfl_xor(s, 1); return s;
}

namespace pg8 {
constexpr int BM = 256, BK = 64, HALF = 128, HTB = HALF * BK * 2, NXCD = 8, WGM = 8;
__device__ __forceinline__ int lds_byte(int r, int c) { const int st = (r >> 4) * 2 + (c >> 5), rr = r & 15, cc = c & 31, ob = rr * 64 + cc * 2; return st * 1024 + (ob ^ (((ob >> 9) & 1) << 5)); }
__device__ __forceinline__ void stage_rc(int b, int& R, int& C) { const int st = b / 1024, sb = b % 1024, swz = sb ^ (((sb >> 9) & 1) << 5); R = (st >> 1) * 16 + swz / 64; C = (st & 1) * 32 + (swz % 64) / 2; }
__device__ __forceinline__ int perm32(int rho) { const int n = rho >> 4, i = rho & 15; return 8 * (i >> 2) + 4 * n + (i & 3); }

struct Unit { int pm, pn; };
struct Gemm { const bf16_t* A; const bf16_t* Bt; int M, N, K, lda, ldb, a_pn_off; };

struct StaticOrder {
    int nM, nN, nwg, G, c, wgm;
    __device__ void init(int M, int N, int G_, int c_, int wgm_ = WGM) { nM = M / BM; nN = N / BM; nwg = nM * nN; G = G_; c = c_; wgm = wgm_; }
    __device__ bool next(int i, Unit& u) const {
        const long L = (long)i * G + c; if (L >= nwg) return false;
        int wgid = (int)L; { const int q = nwg / NXCD, r = nwg % NXCD, xcd = wgid % NXCD, off = wgid / NXCD; wgid = (xcd < r ? xcd * (q + 1) : r * (q + 1) + (xcd - r) * q) + off; }
        const int nig = wgm * nN, gid = wgid / nig, fm = gid * wgm, gsz = (nM - fm) < wgm ? (nM - fm) : wgm;
        u.pm = fm + ((wgid % nig) % gsz); u.pn = (wgid % nig) / gsz; return true;
    }
};

template <class Epi>
__device__ __forceinline__ void gemm_phase(LAS unsigned char* lds, const Gemm g, const StaticOrder& S, const Epi& E) {
    int tid_ = threadIdx.x; asm volatile("" : "+v"(tid_));
    const int tid = tid_, wid = __builtin_amdgcn_readfirstlane(tid >> 6), lane = tid & 63, wr = wid >> 2, wc = wid & 3, fr = lane & 15, fq = lane >> 4;
    const int K = g.K, nt = K / BK;
    unsigned voffA[2], voffB[2];
#pragma unroll
    for (int i = 0; i < 2; ++i) { int R, C; stage_rc(tid * 16 + i * 8192, R, C); const int Rb = (R & ~31) + perm32(R & 31);
        voffA[i] = (unsigned)(R * g.lda + C) * 2u; voffB[i] = (unsigned)(Rb * g.ldb + C) * 2u; }
    const size_t kstep = (size_t)(BK * 2);
    const size_t hstepA = (size_t)HALF * g.lda * 2, hstepB = (size_t)HALF * g.ldb * 2;
    const size_t tstepA = 2 * hstepA, tstepB = 2 * hstepB;
    const unsigned ldsw = (unsigned)wid * 1024u;
    const int aoff = lds_byte(wr * 64 + fr, fq * 8), boff = lds_byte(wc * 32 + fr, fq * 8);
#define PG8_SA(b, h) (((b) * 2 + (h)) * HTB)
#define PG8_SB(b, h) ((4 + (b) * 2 + (h)) * HTB)
#define PG8_STAGE(bufoff, gbase, voff) do { _Pragma("unroll") for (int _i = 0; _i < 2; ++_i) \
        __builtin_amdgcn_global_load_lds((const unsigned*)((const char*)(gbase) + (voff)[_i]), (LAS unsigned*)(lds + (bufoff) + ldsw + _i * 8192), 16, 0, 0); } while (0)
#define PG8_LDA(dst, b, h) do { _Pragma("unroll") for (int m = 0; m < 4; ++m) _Pragma("unroll") for (int k = 0; k < 2; ++k) dst[m][k] = *(const LAS bf16x8*)(lds + PG8_SA(b, h) + aoff + m * 2048 + k * 1024); } while (0)
#define PG8_LDB(dst, b, h) do { _Pragma("unroll") for (int n = 0; n < 2; ++n) _Pragma("unroll") for (int k = 0; k < 2; ++k) dst[n][k] = *(const LAS bf16x8*)(lds + PG8_SB(b, h) + boff + n * 2048 + k * 1024); } while (0)
#define PG8_MMA(ai, bj, At, Bt) do { __builtin_amdgcn_s_setprio(1); _Pragma("unroll") for (int m = 0; m < 4; ++m) _Pragma("unroll") for (int n = 0; n < 2; ++n) _Pragma("unroll") for (int k = 0; k < 2; ++k) \
        acc[ai][bj][m][n] = __builtin_amdgcn_mfma_f32_16x16x32_bf16(Bt[n][k], At[m][k], acc[ai][bj][m][n], 0, 0, 0); __builtin_amdgcn_s_setprio(0); } while (0)
#define PG8_WAIT_V(n) asm volatile("s_waitcnt vmcnt(" #n ")" ::: "memory")
#define PG8_WAIT_L(n) asm volatile("s_waitcnt lgkmcnt(" #n ")" ::: "memory")
#define PG8_BAR __builtin_amdgcn_s_barrier()
#define PG8_SCHED __builtin_amdgcn_sched_barrier(0)
    Unit cur, nxt; int ui = 0, ubuf = 0;
    if (!S.next(0, cur)) return;
    E.prefetch(lds, cur, ubuf, wid, lane);
    f32x4 acc[2][2][4][2];
#pragma unroll
    for (int a = 0; a < 2; ++a)
#pragma unroll
        for (int b = 0; b < 2; ++b)
#pragma unroll
            for (int m = 0; m < 4; ++m)
#pragma unroll
                for (int n = 0; n < 2; ++n) acc[a][b][m][n] = (f32x4){0.f, 0.f, 0.f, 0.f};
    bf16x8 At[4][2], B0[2][2], B1[2][2];
    const char* cA = (const char*)g.A + (size_t)cur.pm * tstepA + (size_t)cur.pn * g.a_pn_off; const char* cB = (const char*)g.Bt + (size_t)cur.pn * tstepB;
    PG8_STAGE(PG8_SB(0, 0), cB, voffB); PG8_STAGE(PG8_SA(0, 0), cA, voffA); PG8_STAGE(PG8_SB(0, 1), cB + hstepB, voffB); PG8_STAGE(PG8_SA(0, 1), cA + hstepA, voffA);
    if (wr == 1) PG8_BAR;
    PG8_WAIT_V(4); PG8_BAR;
    PG8_STAGE(PG8_SB(1, 0), cB + kstep, voffB); PG8_STAGE(PG8_SA(1, 0), cA + kstep, voffA); PG8_STAGE(PG8_SB(1, 1), cB + hstepB + kstep, voffB);
    PG8_WAIT_V(6); PG8_BAR;
    for (;;) {
        const bool has_next = S.next(ui + 1, nxt);
        const char* nA = has_next ? (const char*)g.A + (size_t)nxt.pm * tstepA + (size_t)nxt.pn * g.a_pn_off : cA; const char* nB = has_next ? (const char*)g.Bt + (size_t)nxt.pn * tstepB : cB;
        for (int t = 0; t < nt; t += 2) {
            const bool last = (t == nt - 2);
            const char* a1 = cA + (size_t)(t + 1) * kstep;
            const char* a2 = last ? nA : cA + (size_t)(t + 2) * kstep; const char* b2 = last ? nB : cB + (size_t)(t + 2) * kstep;
            const char* a3 = a2 + kstep; const char* b3 = b2 + kstep;
            PG8_LDB(B0, 0, 0); PG8_SCHED; PG8_LDA(At, 0, 0); PG8_STAGE(PG8_SA(1, 1), a1 + hstepA, voffA);
            PG8_WAIT_L(8); PG8_BAR; PG8_WAIT_L(0); PG8_MMA(0, 0, At, B0); PG8_BAR; PG8_SCHED;
            PG8_LDB(B1, 0, 1); PG8_STAGE(PG8_SB(0, 0), b2, voffB);
            PG8_BAR; PG8_WAIT_L(0); PG8_MMA(0, 1, At, B1); PG8_BAR;
            PG8_LDA(At, 0, 1); PG8_STAGE(PG8_SA(0, 0), a2, voffA);
            PG8_BAR; PG8_WAIT_L(0); PG8_MMA(1, 0, At, B0); PG8_BAR; PG8_SCHED;
            PG8_STAGE(PG8_SB(0, 1), b2 + hstepB, voffB);
            PG8_WAIT_V(6); PG8_BAR; PG8_MMA(1, 1, At, B1); PG8_BAR;
            PG8_LDB(B0, 1, 0); PG8_SCHED; PG8_LDA(At, 1, 0); PG8_STAGE(PG8_SA(0, 1), a2 + hstepA, voffA);
            PG8_WAIT_L(8); PG8_BAR; PG8_WAIT_L(0); PG8_MMA(0, 0, At, B0); PG8_BAR; PG8_SCHED;
            PG8_LDB(B1, 1, 1); PG8_STAGE(PG8_SB(1, 0), b3, voffB);
            PG8_BAR; PG8_WAIT_L(0); PG8_MMA(0, 1, At, B1); PG8_BAR;
            PG8_LDA(At, 1, 1); PG8_STAGE(PG8_SA(1, 0), a3, voffA);
            PG8_BAR; PG8_WAIT_L(0); PG8_MMA(1, 0, At, B0); PG8_BAR; PG8_SCHED;
            PG8_STAGE(PG8_SB(1, 1), b3 + hstepB, voffB);
            PG8_WAIT_V(6); PG8_BAR; PG8_MMA(1, 1, At, B1); PG8_BAR;
        }
        E(acc, cur, wr, wc, fr, fq, lds, ubuf);
        if (!has_next) break;
        ubuf ^= 1; E.prefetch(lds, nxt, ubuf, wid, lane);
#pragma unroll
        for (int a = 0; a < 2; ++a)
#pragma unroll
            for (int b = 0; b < 2; ++b)
#pragma unroll
                for (int m = 0; m < 4; ++m)
#pragma unroll
                    for (int n = 0; n < 2; ++n) acc[a][b][m][n] = (f32x4){0.f, 0.f, 0.f, 0.f};
        cur = nxt; cA = nA; cB = nB; ++ui;
    }
    PG8_WAIT_V(0);
    if (wr == 0) PG8_BAR;
    PG8_BAR;
#undef PG8_SA
#undef PG8_SB
#undef PG8_STAGE
#undef PG8_LDA
#undef PG8_LDB
#undef PG8_MMA
#undef PG8_WAIT_V
#undef PG8_WAIT_L
#undef PG8_BAR
#undef PG8_SCHED
}
}
using pg8::Unit;

__device__ __forceinline__ f32x4 bf4lo(const u32x4 w) { return (f32x4){bflo(w.x), bfhi(w.x), bflo(w.y), bfhi(w.y)}; }
__device__ __forceinline__ f32x4 bf4hi(const u32x4 w) { return (f32x4){bflo(w.z), bfhi(w.z), bflo(w.w), bfhi(w.w)}; }
__device__ __forceinline__ u32x4 pack8(const f32x4 v0, const f32x4 v1) { u32x4 w; w.x = cvt_pk_bf16(v0[0], v0[1]); w.y = cvt_pk_bf16(v0[2], v0[3]); w.z = cvt_pk_bf16(v1[0], v1[1]); w.w = cvt_pk_bf16(v1[2], v1[3]); return w; }
__device__ __forceinline__ float sq8(const f32x4 v0, const f32x4 v1) { return v0[0] * v0[0] + v0[1] * v0[1] + v0[2] * v0[2] + v0[3] * v0[3] + v1[0] * v1[0] + v1[1] * v1[1] + v1[2] * v1[2] + v1[3] * v1[3]; }
struct EpiScaleBf16 {
    bf16_t* O; int ldc; const float* ss; const float* cscale;
    __device__ __forceinline__ void prefetch(LAS unsigned char*, const Unit&, int, int, int) const {}
    __device__ __forceinline__ void operator()(const f32x4 (&acc)[2][2][4][2], const Unit& u, int wr, int wc, int fr, int fq, LAS unsigned char* lds, int ubuf) const {
        const int row0 = u.pm * 256 + wr * 64 + fr, col0 = u.pn * 256 + wc * 32 + 8 * fq;
        f32x4 cs[2][2]; float rsv[2][4];
#pragma unroll
        for (int bj = 0; bj < 2; ++bj)
#pragma unroll
            for (int n = 0; n < 2; ++n) cs[bj][n] = cscale ? *(const f32x4*)(cscale + col0 + bj * 128 + 4 * n) : (f32x4){1.f, 1.f, 1.f, 1.f};
#pragma unroll
        for (int ai = 0; ai < 2; ++ai)
#pragma unroll
            for (int m = 0; m < 4; ++m) rsv[ai][m] = ss ? ss[row0 + ai * 128 + m * 16] : 0.f;
        __builtin_amdgcn_sched_barrier(0);
#pragma unroll
        for (int ai = 0; ai < 2; ++ai)
#pragma unroll
            for (int m = 0; m < 4; ++m) {
                const int row = row0 + ai * 128 + m * 16;
                const float rs = ss ? rsqrtf(rsv[ai][m] * (1.0f / 2048.0f) + NORM_EPS) : 1.0f;
                bf16_t* rowp = O + (size_t)row * ldc + col0;
#pragma unroll
                for (int bj = 0; bj < 2; ++bj) *(u32x4*)(rowp + bj * 128) = pack8(acc[ai][bj][m][0] * rs * cs[bj][0], acc[ai][bj][m][1] * rs * cs[bj][1]);
            }
    }
};
template <bool RF32> struct EpiRes {
    const void* res; bf16_t* ob; float* ssq;
    __device__ __forceinline__ void prefetch(LAS unsigned char*, const Unit&, int, int, int) const {}
    __device__ __forceinline__ void operator()(const f32x4 (&acc)[2][2][4][2], const Unit& u, int wr, int wc, int fr, int fq, LAS unsigned char* lds, int ubuf) const {
        const int row0 = u.pm * 256 + wr * 64 + fr, col0 = u.pn * 256 + wc * 32 + 8 * fq;
        if constexpr (RF32) {
#pragma unroll
            for (int ai = 0; ai < 2; ++ai) {
                f32x4 r0[4][2], r1[4][2];
#pragma unroll
                for (int m = 0; m < 4; ++m)
#pragma unroll
                    for (int bj = 0; bj < 2; ++bj) {
                        const size_t o = (size_t)(row0 + ai * 128 + m * 16) * DM + col0 + bj * 128;
                        r0[m][bj] = *(const f32x4*)((const float*)res + o); r1[m][bj] = *(const f32x4*)((const float*)res + o + 4);
                    }
                __builtin_amdgcn_sched_barrier(0);
#pragma unroll
                for (int m = 0; m < 4; ++m) {
                    const int row = row0 + ai * 128 + m * 16;
                    float s = 0.f;
#pragma unroll
                    for (int bj = 0; bj < 2; ++bj) {
                        const size_t o = (size_t)row * DM + col0 + bj * 128;
                        const f32x4 v0 = acc[ai][bj][m][0] + r0[m][bj], v1 = acc[ai][bj][m][1] + r1[m][bj];
                        *(u32x4*)(ob + o) = pack8(v0, v1);
                        s += sq8(v0, v1);
                    }
                    s += __shfl_xor(s, 16); s += __shfl_xor(s, 32);
                    if (fq == 0) unsafeAtomicAdd(ssq + row, s);
                }
            }
        } else {
            u32x4 pw[2][4][2];
#pragma unroll
            for (int ai = 0; ai < 2; ++ai)
#pragma unroll
                for (int m = 0; m < 4; ++m)
#pragma unroll
                    for (int bj = 0; bj < 2; ++bj) pw[ai][m][bj] = *(const u32x4*)((const bf16_t*)res + (size_t)(row0 + ai * 128 + m * 16) * DM + col0 + bj * 128);
            __builtin_amdgcn_sched_barrier(0);
#pragma unroll
            for (int ai = 0; ai < 2; ++ai)
#pragma unroll
                for (int m = 0; m < 4; ++m) {
                    const int row = row0 + ai * 128 + m * 16;
                    float s = 0.f;
#pragma unroll
                    for (int bj = 0; bj < 2; ++bj) {
                        const size_t o = (size_t)row * DM + col0 + bj * 128;
                        const f32x4 v0 = acc[ai][bj][m][0] + bf4lo(pw[ai][m][bj]), v1 = acc[ai][bj][m][1] + bf4hi(pw[ai][m][bj]);
                        *(u32x4*)(ob + o) = pack8(v0, v1);
                        s += sq8(v0, v1);
                    }
                    s += __shfl_xor(s, 16); s += __shfl_xor(s, 32);
                    if (fq == 0) unsafeAtomicAdd(ssq + row, s);
                }
        }
    }
};
struct EpiGate {
    const bf16_t* h2b; bf16_t* h3b; const bf16_t* proj; const float* ss3; float* ss4;
    __device__ __forceinline__ void prefetch(LAS unsigned char*, const Unit&, int, int, int) const {}
    __device__ __forceinline__ void operator()(const f32x4 (&acc)[2][2][4][2], const Unit& u, int wr, int wc, int fr, int fq, LAS unsigned char* lds, int ubuf) const {
        const int row0 = u.pm * 256 + wr * 64 + fr, col0 = u.pn * 256 + wc * 32 + 8 * fq;
#pragma unroll
        for (int ai = 0; ai < 2; ++ai) {
            u32x4 hw[4][2], pw[4][2]; float rsv[4];
#pragma unroll
            for (int m = 0; m < 4; ++m) {
                rsv[m] = ss3[row0 + ai * 128 + m * 16];
#pragma unroll
                for (int bj = 0; bj < 2; ++bj) {
                    const size_t o = (size_t)(row0 + ai * 128 + m * 16) * DM + col0 + bj * 128;
                    hw[m][bj] = *(const u32x4*)(h2b + o); pw[m][bj] = *(const u32x4*)(proj + o);
                }
            }
            __builtin_amdgcn_sched_barrier(0);
#pragma unroll
            for (int m = 0; m < 4; ++m) {
                const int row = row0 + ai * 128 + m * 16;
                const float rs = rsqrtf(rsv[m] * (1.0f / 2048.0f) + NORM_EPS);
                float s = 0.f;
#pragma unroll
                for (int bj = 0; bj < 2; ++bj) {
                    const size_t o = (size_t)row * DM + col0 + bj * 128;
                    const f32x4 r0 = bf4lo(hw[m][bj]), r1 = bf4hi(hw[m][bj]), p0 = bf4lo(pw[m][bj]), p1 = bf4hi(pw[m][bj]);
                    f32x4 v0, v1;
#pragma unroll
                    for (int j = 0; j < 4; ++j) { v0[j] = r0[j] + sigmoidf_(acc[ai][bj][m][0][j] * rs) * p0[j]; v1[j] = r1[j] + sigmoidf_(acc[ai][bj][m][1][j] * rs) * p1[j]; }
                    *(u32x4*)(h3b + o) = pack8(v0, v1);
                    s += sq8(v0, v1);
                }
                s += __shfl_xor(s, 16); s += __shfl_xor(s, 32);
                if (fq == 0) unsafeAtomicAdd(ss4 + row, s);
            }
        }
    }
};
struct EpiUp {
    bf16_t* act; float* edge; const float* ss2; const float* conv_w; const float* conv_b;
    __device__ __forceinline__ void prefetch(LAS unsigned char* lds, const Unit& u, int ubuf, int wid, int lane) const {
        if (wid < 5) {
            const int p = wid * 64 + lane, a = p >> 5, wi = p & 31;
            const float* src;
            if (a < 8) { const int par = a & 3, f = (a >> 2) * DFF + u.pn * 128 + 4 * wi; src = (par < 3) ? conv_w + par * UPC + f : conv_b + f; }
            else src = ss2 + u.pm * 256 + (p - 256) * 4;
            __builtin_amdgcn_global_load_lds((const unsigned*)src, (LAS unsigned*)(lds + EPI_LDS + ubuf * 8192 + wid * 1024), 16, 0, 0);
        }
    }
    __device__ __forceinline__ void operator()(const f32x4 (&acc)[2][2][4][2], const Unit& u, int wr, int wc, int fr, int fq, LAS unsigned char* lds, int ubuf) const {
        const LAS float* pp = (const LAS float*)(lds + EPI_LDS + ubuf * 8192);
        float rsv[2][4];
#pragma unroll
        for (int ai = 0; ai < 2; ++ai)
#pragma unroll
            for (int m = 0; m < 4; ++m) rsv[ai][m] = rsqrtf(pp[1024 + ai * 128 + wr * 64 + m * 16 + fr] * (1.0f / 2048.0f) + NORM_EPS);
#pragma unroll
        for (int n = 0; n < 2; ++n) {
            const int cf = wc * 32 + 8 * fq + 4 * n;
            const int f = u.pn * 128 + cf;
            const f32x4 w0g = *(const LAS f32x4*)(pp + cf), w1g = *(const LAS f32x4*)(pp + 128 + cf), w2g = *(const LAS f32x4*)(pp + 256 + cf), bg = *(const LAS f32x4*)(pp + 384 + cf);
            const f32x4 w0v = *(const LAS f32x4*)(pp + 512 + cf), w1v = *(const LAS f32x4*)(pp + 640 + cf), w2v = *(const LAS f32x4*)(pp + 768 + cf), bv = *(const LAS f32x4*)(pp + 896 + cf);
#pragma unroll
            for (int ai = 0; ai < 2; ++ai) {
                const int run = u.pm * 4 + ai * 2 + wr;
                float* eg = edge + (size_t)run * 4 * UPC + u.pn * 256 + cf;
                f32x4 pG = {0.f, 0.f, 0.f, 0.f}, pV = {0.f, 0.f, 0.f, 0.f};
#pragma unroll
                for (int m = 0; m < 4; ++m) {
                    const int row = run * 64 + m * 16 + fr;
                    const float rs = rsv[ai][m];
                    const f32x4 G = acc[ai][0][m][n] * rs, V = acc[ai][1][m][n] * rs;
                    if (m == 0 && fr < 2) { *(f32x4*)(eg + (size_t)fr * UPC) = G; *(f32x4*)(eg + (size_t)fr * UPC + 128) = V; }
                    if (m == 3 && fr >= 14) { *(f32x4*)(eg + (size_t)(fr - 12) * UPC) = G; *(f32x4*)(eg + (size_t)(fr - 12) * UPC + 128) = V; }
                    f32x4 g1, g2, v1, v2;
#pragma unroll
                    for (int j = 0; j < 4; ++j) {
                        g1[j] = dpp_o<0x111>(dpp_f<0x10F>(pG[j]), G[j]); g2[j] = dpp_o<0x112>(dpp_f<0x10E>(pG[j]), G[j]);
                        v1[j] = dpp_o<0x111>(dpp_f<0x10F>(pV[j]), V[j]); v2[j] = dpp_o<0x112>(dpp_f<0x10E>(pV[j]), V[j]);
                    }
                    const f32x4 gate = bg + w2g * G + w1g * g1 + w0g * g2;
                    const f32x4 val = bv + w2v * V + w1v * v1 + w0v * v2;
                    f32x4 a;
#pragma unroll
                    for (int j = 0; j < 4; ++j) a[j] = gate[j] * sigmoidf_(gate[j]) * val[j];
                    u32x2 w; w.x = cvt_pk_bf16(a[0], a[1]); w.y = cvt_pk_bf16(a[2], a[3]);
                    *(u32x2*)(act + (size_t)row * DFF + f) = w;
                    pG = G; pV = V;
                }
            }
        }
    }
};

struct WtJob { const float* W; const float* scale; bf16_t* Bt; int ldw, ldb, k0, n0, up; };
__device__ __forceinline__ bool wt_job(const Params& P, int id, WtJob& j) {
    unsigned char* ws = P.ws;
    const int T0 = 640, T1 = T0 + 1376, T2 = T1 + 688, T3 = T2 + 256, T4 = T3 + 256, T5 = T4 + 32, T6 = T5 + 16;
    if (id >= T6) return false;
    j.up = 0;
    if (id < T0) { const int nt = id % 20, kt = id / 20; j = WtJob{P.w_in, P.norm1_w, (bf16_t*)(ws + OFF_WIN), INC, DM, kt * 64, nt * 256, 0}; }
    else if (id < T1) { const int l = id - T0, nt = l % 43, kt = l / 43; j = WtJob{P.w_up, P.norm2_w, (bf16_t*)(ws + OFF_WUP), UPC, DM, kt * 64, nt * 256, 1}; }
    else if (id < T2) { const int l = id - T1, nt = l % 8, kt = l / 8; j = WtJob{P.w_down, nullptr, (bf16_t*)(ws + OFF_WDOWN), DM, DFF, kt * 64, nt * 256, 0}; }
    else if (id < T3) { const int l = id - T2, nt = l % 8, kt = l / 8; j = WtJob{P.w_out, nullptr, (bf16_t*)(ws + OFF_WOUT), DM, DM, kt * 64, nt * 256, 0}; }
    else if (id < T4) { const int l = id - T3, nt = l % 8, kt = l / 8; j = WtJob{P.ple_gate_w, P.norm3_w, (bf16_t*)(ws + OFF_WGATE), DM, DM, kt * 64, nt * 256, 0}; }
    else if (id < T5) { const int l = id - T4, nt = l % 8, kt = l / 8; j = WtJob{P.ple_proj_w, nullptr, (bf16_t*)(ws + OFF_WPROJ), DM, PLE, kt * 64, nt * 256, 0}; }
    else { const int l = id - T5, g = l >> 2, kt = l & 3; j = WtJob{P.pool_w + g * 65536, nullptr, (bf16_t*)(ws + OFF_POOLT) + g * 65536, 256, 256, kt * 64, 0, 0}; }
    return true;
}
__device__ __forceinline__ void wt_load(const WtJob& j, f32x4 (&v)[8]) {
    const int c4 = (threadIdx.x & 63) * 4, r = threadIdx.x >> 6;
#pragma unroll
    for (int i = 0; i < 8; ++i) v[i] = *(const f32x4*)(j.W + (size_t)(j.k0 + r + 8 * i) * j.ldw + j.n0 + c4);
}
__device__ __forceinline__ void wt_put(const WtJob& j, const f32x4 (&v)[8], float* tile) {
    const int c4 = (threadIdx.x & 63) * 4, r = threadIdx.x >> 6;
#pragma unroll
    for (int i = 0; i < 8; ++i) { const int k = r + 8 * i; const float sc = j.scale ? j.scale[j.k0 + k] : 1.0f; *(f32x4*)(tile + k * 260 + (c4 ^ (4 * i))) = v[i] * sc; }
}
__device__ __forceinline__ void wt_store(const WtJob& j, const float* tile) {
#pragma unroll
    for (int it = 0; it < 4; ++it) {
        const int item = threadIdx.x + 512 * it, n = item >> 3, ko = item & 7; float v[8];
#pragma unroll
        for (int i = 0; i < 8; ++i) v[i] = tile[(ko * 8 + i) * 260 + (n ^ (4 * ko))];
        int nn = j.n0 + n;
        if (j.up) { const int half = nn >= DFF ? 1 : 0, f = nn - half * DFF; nn = 256 * (f >> 7) + 128 * half + (f & 127); }
        u32x4 w; w.x = cvt_pk_bf16(v[0], v[1]); w.y = cvt_pk_bf16(v[2], v[3]); w.z = cvt_pk_bf16(v[4], v[5]); w.w = cvt_pk_bf16(v[6], v[7]);
        *(u32x4*)(j.Bt + (size_t)nn * j.ldb + j.k0 + ko * 8) = w;
    }
}

__device__ void wt_convert(const Params& P, unsigned char* shm, int lo, int hi) {
    float* tile = (float*)shm; WtJob cur, nxt; f32x4 v[8];
    int id = lo + blockIdx.x; bool have = id < hi && wt_job(P, id, cur);
    if (have) wt_load(cur, v);
    while (have) {
        wt_put(cur, v, tile);
        __syncthreads();
        id += gridDim.x; const bool hn = id < hi && wt_job(P, id, nxt);
        if (hn) wt_load(nxt, v);
        wt_store(cur, tile);
        __syncthreads();
        cur = nxt; have = hn;
    }
}
__device__ void ph_prologue(const Params& P, unsigned char* shm) {
    const int tid = threadIdx.x, lane = tid & 63, wid = tid >> 6;
    const int gw = blockIdx.x * 8 + wid, nw = gridDim.x * 8;
    const int gt = blockIdx.x * 512 + tid, ntot = gridDim.x * 512;
    unsigned char* ws = P.ws;
    { bf16_t* xb = (bf16_t*)(ws + OFF_XB); float* ss1 = (float*)(ws + OFF_SUMSQ);
      for (int row = gw; row < NTOK; row += nw) {
          const f32x4* src = (const f32x4*)(P.x + (size_t)row * DM); u32x2* dst = (u32x2*)(xb + (size_t)row * DM); float s = 0.f;
#pragma unroll
          for (int i = 0; i < 8; ++i) { const f32x4 v = src[i * 64 + lane]; s += v[0] * v[0] + v[1] * v[1] + v[2] * v[2] + v[3] * v[3];
              u32x2 w; w.x = cvt_pk_bf16(v[0], v[1]); w.y = cvt_pk_bf16(v[2], v[3]); dst[i * 64 + lane] = w; }
          s = wave_sum(s); if (lane == 0) ss1[row] = s; } }
    { const f32x4* src = (const f32x4*)P.p; u32x2* dst = (u32x2*)(ws + OFF_PB);
      for (int i = gt; i < NTOK * PLE / 4; i += ntot) { const f32x4 v = src[i]; u32x2 w; w.x = cvt_pk_bf16(v[0], v[1]); w.y = cvt_pk_bf16(v[2], v[3]); dst[i] = w; } }
    { float* ss = (float*)(ws + OFF_SUMSQ) + NTOK; for (int i = gt; i < 3 * NTOK; i += ntot) ss[i] = 0.f; }
    { float* ct = (float*)(ws + OFF_COS); float* st = (float*)(ws + OFF_SIN);
      for (int i = gt; i < SEQ * 64; i += ntot) { const int pos = i >> 6, fi = i & 63; const float ang = (float)pos * P.inv_freq[fi];
          double rev = (double)ang * 0.15915494309189533577; rev -= rint(rev); const float rv = (float)rev;
          ct[i] = __builtin_amdgcn_cosf(rv); st[i] = __builtin_amdgcn_sinf(rv); } }
    wt_convert(P, shm, 0, 640);
    wt_convert(P, shm, 3248, 3264);
}

__device__ __forceinline__ void bf8_acc(float (&s)[8], const u32x4 v, float sg) {
    s[0] += sg * bflo(v.x); s[1] += sg * bfhi(v.x); s[2] += sg * bflo(v.y); s[3] += sg * bfhi(v.y); s[4] += sg * bflo(v.z); s[5] += sg * bfhi(v.z); s[6] += sg * bflo(v.w); s[7] += sg * bfhi(v.w);
}
__device__ void ph_pool_diff(const Params& P) {
    const bf16_t* __restrict__ z = (const bf16_t*)(P.ws + OFF_Z); bf16_t* __restrict__ diff = (bf16_t*)(P.ws + OFF_DIFF);
    for (int it = blockIdx.x * 512 + threadIdx.x; it < 1024 * 128; it += gridDim.x * 512) {
        const int strip = it >> 7, oc = it & 127; const int R0 = strip * 16, s0 = R0 & (SEQ - 1); const int w = 2 << (oc >> 5);
        const bf16_t* zc = z + 8 * oc;
        float s[8];
#pragma unroll
        for (int i = 0; i < 8; ++i) s[i] = 0.f;
        if (s0 > 0) {
            u32x4 pv[16];
#pragma unroll
            for (int d = 1; d <= 16; ++d) pv[d - 1] = (d <= w) ? *(const u32x4*)(zc + (size_t)(R0 - d) * INC) : (u32x4){0u, 0u, 0u, 0u};
#pragma unroll
            for (int d = 1; d <= 16; ++d) bf8_acc(s, pv[d - 1], 1.0f);
        }
#pragma unroll
        for (int half = 0; half < 2; ++half) {
            u32x4 cu[8], od[8];
#pragma unroll
            for (int r = 0; r < 8; ++r) { const int rr = half * 8 + r; cu[r] = *(const u32x4*)(zc + (size_t)(R0 + rr) * INC);
                od[r] = (s0 + rr - w >= 0) ? *(const u32x4*)(zc + (size_t)(R0 + rr - w) * INC) : (u32x4){0u, 0u, 0u, 0u}; }
#pragma unroll
            for (int r = 0; r < 8; ++r) {
                const int rr = half * 8 + r, t = s0 + rr;
                bf8_acc(s, cu[r], 1.0f); bf8_acc(s, od[r], -1.0f);
                const float inv = 1.0f / (float)(t + 1 < w ? t + 1 : w);
                const u32x4 v = cu[r];
                u32x4 ow; ow.x = cvt_pk_bf16(s[0] * inv - bflo(v.x), s[1] * inv - bfhi(v.x)); ow.y = cvt_pk_bf16(s[2] * inv - bflo(v.y), s[3] * inv - bfhi(v.y));
                ow.z = cvt_pk_bf16(s[4] * inv - bflo(v.z), s[5] * inv - bfhi(v.z)); ow.w = cvt_pk_bf16(s[6] * inv - bflo(v.w), s[7] * inv - bfhi(v.w));
                *(u32x4*)(diff + (size_t)(R0 + rr) * 1024 + 8 * oc) = ow;
            }
        }
    }
}

constexpr int LP = 144;
struct KRaw { u32x4 a, c; f32x4 c0, c1, s0, s1; };
__device__ __forceinline__ void k_load(const bf16_t* z, const float* cosT, const float* sinT, int b, int h, int n, int it, KRaw& r) {
    const int j = it >> 3, o = it & 7, pos = n * 128 + j; const size_t t = (size_t)b * SEQ + pos;
    const bf16_t* kp = z + t * INC + 2048 + h * 128 + 8 * o;
    r.a = *(const u32x4*)kp; r.c = *(const u32x4*)(kp + 64);
    r.c0 = *(const f32x4*)(cosT + pos * 64 + 8 * o); r.c1 = *(const f32x4*)(cosT + pos * 64 + 8 * o + 4);
    r.s0 = *(const f32x4*)(sinT + pos * 64 + 8 * o); r.s1 = *(const f32x4*)(sinT + pos * 64 + 8 * o + 4);
}
template <bool TR, bool ZETA = TR> __device__ __forceinline__ void k_put(const KRaw& r, int it, float log2g, bf16_t* dst) {
    const int j = it >> 3, o = it & 7;
    const float sc = 0.08838834764831845f * (ZETA ? exp2f((float)(127 - j) * log2g) : 1.0f);
    const float x1[8] = {bflo(r.a.x), bfhi(r.a.x), bflo(r.a.y), bfhi(r.a.y), bflo(r.a.z), bfhi(r.a.z), bflo(r.a.w), bfhi(r.a.w)};
    const float x2[8] = {bflo(r.c.x), bfhi(r.c.x), bflo(r.c.y), bfhi(r.c.y), bflo(r.c.z), bfhi(r.c.z), bflo(r.c.w), bfhi(r.c.w)};
    const float cc[8] = {r.c0[0], r.c0[1], r.c0[2], r.c0[3], r.c1[0], r.c1[1], r.c1[2], r.c1[3]}, ss[8] = {r.s0[0], r.s0[1], r.s0[2], r.s0[3], r.s1[0], r.s1[1], r.s1[2], r.s1[3]};
    float o1[8], o2[8];
#pragma unroll
    for (int i = 0; i < 8; ++i) { o1[i] = (x1[i] * cc[i] - x2[i] * ss[i]) * sc; o2[i] = (x2[i] * cc[i] + x1[i] * ss[i]) * sc; }
    if (TR) {
#pragma unroll
        for (int i = 0; i < 8; ++i) { const unsigned pk = cvt_pk_bf16(o1[i], o2[i]); dst[(8 * o + i) * LP + j] = (bf16_t)(pk & 0xffffu); dst[(64 + 8 * o + i) * LP + j] = (bf16_t)(pk >> 16); }
    } else {
        u32x4 w1, w2; w1.x = cvt_pk_bf16(o1[0], o1[1]); w1.y = cvt_pk_bf16(o1[2], o1[3]); w1.z = cvt_pk_bf16(o1[4], o1[5]); w1.w = cvt_pk_bf16(o1[6], o1[7]);
        w2.x = cvt_pk_bf16(o2[0], o2[1]); w2.y = cvt_pk_bf16(o2[2], o2[3]); w2.z = cvt_pk_bf16(o2[4], o2[5]); w2.w = cvt_pk_bf16(o2[6], o2[7]);
        *(u32x4*)(dst + j * LP + 8 * o) = w1; *(u32x4*)(dst + j * LP + 64 + 8 * o) = w2;
    }
}
__device__ __forceinline__ u32x4 v_load(const bf16_t* z, int b, int h, int n, int it) {
    const int j = it >> 4, o = it & 15; const size_t t = (size_t)b * SEQ + n * 128 + j;
    return *(const u32x4*)(z + t * INC + 3072 + h * 128 + 8 * o);
}
__device__ __forceinline__ void v_put(const u32x4 v, int it, bf16_t* dst) {
    const int j = it >> 4, o = it & 15; const unsigned w[4] = {v.x, v.y, v.z, v.w};
#pragma unroll
    for (int i = 0; i < 4; ++i) { dst[(8 * o + 2 * i) * LP + j] = (bf16_t)(w[i] & 0xffffu); dst[(8 * o + 2 * i + 1) * LP + j] = (bf16_t)(w[i] >> 16); }
}

__device__ __forceinline__ void v_put_nat(const u32x4 v, int it, bf16_t* dst) { *(u32x4*)(dst + (it >> 4) * LP + (it & 15) * 8) = v; }
#define TRD(i, off) "ds_read_b64_tr_b16 %" #i ", %16 offset:" off "\n\t"
#define TR16(R, ADDR, S2) asm volatile( \
    TRD(0, "0") TRD(1, S2) TRD(2, "32") TRD(3, "32+" S2) TRD(4, "64") TRD(5, "64+" S2) TRD(6, "96") TRD(7, "96+" S2) \
    TRD(8, "128") TRD(9, "128+" S2) TRD(10, "160") TRD(11, "160+" S2) TRD(12, "192") TRD(13, "192+" S2) TRD(14, "224") TRD(15, "224+" S2) \
    "s_waitcnt lgkmcnt(0)" \
    : "=&v"(R[0][0]), "=&v"(R[0][1]), "=&v"(R[1][0]), "=&v"(R[1][1]), "=&v"(R[2][0]), "=&v"(R[2][1]), "=&v"(R[3][0]), "=&v"(R[3][1]), \
      "=&v"(R[4][0]), "=&v"(R[4][1]), "=&v"(R[5][0]), "=&v"(R[5][1]), "=&v"(R[6][0]), "=&v"(R[6][1]), "=&v"(R[7][0]), "=&v"(R[7][1]) \
    : "v"(ADDR) : "memory")
__device__ __forceinline__ bf16x8 cat8(const u32x2 lo, const u32x2 hi) { u32x4 w; w.x = lo.x; w.y = lo.y; w.z = hi.x; w.w = hi.y; return __builtin_bit_cast(bf16x8, w); }

__device__ void ph_ret_kv(const Params& P, unsigned char* shm) {
    const bf16_t* z = (const bf16_t*)(P.ws + OFF_Z); const float* cosT = (const float*)(P.ws + OFF_COS); const float* sinT = (const float*)(P.ws + OFF_SIN);
    bf16_t* kvT = (bf16_t*)(P.ws + OFF_KVT);
    bf16_t* kn = (bf16_t*)shm; bf16_t* vn = kn + 128 * LP;
    const int tid = threadIdx.x, w = __builtin_amdgcn_readfirstlane(tid >> 6), lane = tid & 63, fr = lane & 15, fq = lane >> 4;
    const unsigned lbase = (unsigned)(size_t)(LAS unsigned char*)shm;
    const unsigned tro = (unsigned)(((8 * fq + (fr >> 2)) * LP + 4 * (fr & 3)) * 2);
    KRaw kr[2]; u32x4 vr[4];
    int ui = blockIdx.x;
    if (ui < 960) { const int bh = ui / 15, n = ui - bh * 15, h = bh & 7, b = bh >> 3;
#pragma unroll
        for (int i = 0; i < 4; ++i) vr[i] = v_load(z, b, h, n, tid + 512 * i);
#pragma unroll
        for (int i = 0; i < 2; ++i) k_load(z, cosT, sinT, b, h, n, tid + 512 * i, kr[i]); }
    for (; ui < 960; ui += gridDim.x) {
        const int bh = ui / 15, n = ui - bh * 15, h = bh & 7, unit = bh * 16 + n;
#pragma unroll
        for (int i = 0; i < 4; ++i) v_put_nat(vr[i], tid + 512 * i, vn);
#pragma unroll
        for (int i = 0; i < 2; ++i) k_put<false, true>(kr[i], tid + 512 * i, P.log2g[h], kn);
        __syncthreads();
        { const int un = ui + gridDim.x;
          if (un < 960) { const int bh2 = un / 15, n2 = un - bh2 * 15, h2 = bh2 & 7, b2 = bh2 >> 3;
#pragma unroll
              for (int i = 0; i < 4; ++i) vr[i] = v_load(z, b2, h2, n2, tid + 512 * i);
#pragma unroll
              for (int i = 0; i < 2; ++i) k_load(z, cosT, sinT, b2, h2, n2, tid + 512 * i, kr[i]); } }
        f32x4 acc[8];
#pragma unroll
        for (int eb = 0; eb < 8; ++eb) acc[eb] = (f32x4){0.f, 0.f, 0.f, 0.f};
#pragma unroll
        for (int ks = 0; ks < 4; ++ks) {
            const unsigned ka = lbase + tro + (unsigned)(ks * 32 * LP * 2 + 16 * w * 2);
            u32x2 a0, a1;
            asm volatile("ds_read_b64_tr_b16 %0, %2\n\tds_read_b64_tr_b16 %1, %2 offset:1152\n\ts_waitcnt lgkmcnt(0)" : "=&v"(a0), "=&v"(a1) : "v"(ka) : "memory");
            const bf16x8 a = cat8(a0, a1);
            const unsigned va = lbase + (unsigned)(128 * LP * 2) + tro + (unsigned)(ks * 32 * LP * 2);
            u32x2 R[8][2];
            TR16(R, va, "1152");
#pragma unroll
            for (int eb = 0; eb < 8; ++eb) acc[eb] = __builtin_amdgcn_mfma_f32_16x16x32_bf16(a, cat8(R[eb][0], R[eb][1]), acc[eb], 0, 0, 0);
        }
        bf16_t* dst = kvT + (size_t)unit * 16384;
#pragma unroll
        for (int eb = 0; eb < 8; ++eb) { u32x2 kw; kw.x = cvt_pk_bf16(acc[eb][0], acc[eb][1]); kw.y = cvt_pk_bf16(acc[eb][2], acc[eb][3]); *(u32x2*)(dst + (16 * eb + fr) * 128 + 16 * w + 4 * fq) = kw; }
        __syncthreads();
    }
}
__device__ void ph_ret_scan(const Params& P) {
    const bf16_t* kvT = (const bf16_t*)(P.ws + OFF_KVT); bf16_t* RT = (bf16_t*)(P.ws + OFF_RT);
    for (int it = blockIdx.x * 512 + threadIdx.x; it < 64 * 4096; it += gridDim.x * 512) {
        const int bh = it >> 12, q4 = it & 4095; const float gc = exp2f(128.0f * P.log2g[bh & 7]);
        const size_t o0 = ((size_t)(bh * 16)) * 16384 + 4 * q4;
        u32x2 kv[15];
#pragma unroll
        for (int n = 0; n < 15; ++n) kv[n] = *(const u32x2*)(kvT + o0 + (size_t)n * 16384);
        f32x4 R = {0.f, 0.f, 0.f, 0.f};
#pragma unroll
        for (int n = 0; n < 16; ++n) {
            u32x2 w; w.x = cvt_pk_bf16(R[0], R[1]); w.y = cvt_pk_bf16(R[2], R[3]); *(u32x2*)(RT + o0 + (size_t)n * 16384) = w;
            if (n < 15) R = R * gc + (f32x4){bflo(kv[n].x), bfhi(kv[n].x), bflo(kv[n].y), bfhi(kv[n].y)};
        }
    }
}
__device__ void ph_ret_out(const Params& P, unsigned char* shm) {
    const bf16_t* z = (const bf16_t*)(P.ws + OFF_Z); const float* cosT = (const float*)(P.ws + OFF_COS); const float* sinT = (const float*)(P.ws + OFF_SIN);
    const bf16_t* RT = (const bf16_t*)(P.ws + OFF_RT); bf16_t* mix = (bf16_t*)(P.ws + OFF_MIX);
    bf16_t* kn = (bf16_t*)shm; bf16_t* vn = kn + 128 * LP; bf16_t* rts = vn + 128 * LP;
    const unsigned lbase = (unsigned)(size_t)(LAS unsigned char*)shm;
    const int tid = threadIdx.x, w = __builtin_amdgcn_readfirstlane(tid >> 6), lane = tid & 63, fr = lane & 15, fq = lane >> 4;
    for (int unit = blockIdx.x; unit < 1024; unit += gridDim.x) {
        const int n = unit & 15, h = (unit >> 4) & 7, b = unit >> 7; const float log2g = P.log2g[h];
        const int il = 16 * w + fr, pos = n * 128 + il; const size_t t = (size_t)b * SEQ + pos;
        KRaw kr[2]; u32x4 vr[4], rr[4]; KRaw qr[2]; u32x2 gg[8];
#pragma unroll
        for (int i = 0; i < 4; ++i) vr[i] = v_load(z, b, h, n, tid + 512 * i);
#pragma unroll
        for (int i = 0; i < 2; ++i) k_load(z, cosT, sinT, b, h, n, tid + 512 * i, kr[i]);
        if (n > 0) {
#pragma unroll
            for (int i = 0; i < 4; ++i) { const int it = tid + 512 * i; rr[i] = *(const u32x4*)(RT + (size_t)unit * 16384 + (it >> 4) * 128 + (it & 15) * 8); }
        }
#pragma unroll
        for (int kp = 0; kp < 2; ++kp) {
            const int d0 = 8 * fq + 32 * kp; const bf16_t* qp = z + t * INC + 1024 + h * 128 + d0;
            qr[kp].a = *(const u32x4*)qp; qr[kp].c = *(const u32x4*)(qp + 64);
            qr[kp].c0 = *(const f32x4*)(cosT + pos * 64 + d0); qr[kp].c1 = *(const f32x4*)(cosT + pos * 64 + d0 + 4);
            qr[kp].s0 = *(const f32x4*)(sinT + pos * 64 + d0); qr[kp].s1 = *(const f32x4*)(sinT + pos * 64 + d0 + 4);
        }
#pragma unroll
        for (int eb = 0; eb < 8; ++eb) gg[eb] = *(const u32x2*)(z + t * INC + 4096 + h * 128 + 16 * eb + 4 * fq);
        f32x4 gwv[8];
#pragma unroll
        for (int eb = 0; eb < 8; ++eb) gwv[eb] = *(const f32x4*)(P.ret_gn_w + h * 128 + 16 * eb + 4 * fq);
        __builtin_amdgcn_sched_barrier(0);
#pragma unroll
        for (int i = 0; i < 4; ++i) v_put_nat(vr[i], tid + 512 * i, vn);
#pragma unroll
        for (int i = 0; i < 2; ++i) k_put<false>(kr[i], tid + 512 * i, log2g, kn);
        if (n > 0) {
#pragma unroll
            for (int i = 0; i < 4; ++i) { const int it = tid + 512 * i; *(u32x4*)(rts + (it >> 4) * LP + (it & 15) * 8) = rr[i]; }
        }
        bf16x8 qf[4];
#pragma unroll
        for (int kp = 0; kp < 2; ++kp) {
            const u32x4 a = qr[kp].a, c = qr[kp].c;
            const float x1[8] = {bflo(a.x), bfhi(a.x), bflo(a.y), bfhi(a.y), bflo(a.z), bfhi(a.z), bflo(a.w), bfhi(a.w)};
            const float x2[8] = {bflo(c.x), bfhi(c.x), bflo(c.y), bfhi(c.y), bflo(c.z), bfhi(c.z), bflo(c.w), bfhi(c.w)};
            const float cc[8] = {qr[kp].c0[0], qr[kp].c0[1], qr[kp].c0[2], qr[kp].c0[3], qr[kp].c1[0], qr[kp].c1[1], qr[kp].c1[2], qr[kp].c1[3]};
            const float ss[8] = {qr[kp].s0[0], qr[kp].s0[1], qr[kp].s0[2], qr[kp].s0[3], qr[kp].s1[0], qr[kp].s1[1], qr[kp].s1[2], qr[kp].s1[3]};
            float o1[8], o2[8];
#pragma unroll
            for (int i = 0; i < 8; ++i) { o1[i] = x1[i] * cc[i] - x2[i] * ss[i]; o2[i] = x2[i] * cc[i] + x1[i] * ss[i]; }
            u32x4 w1, w2; w1.x = cvt_pk_bf16(o1[0], o1[1]); w1.y = cvt_pk_bf16(o1[2], o1[3]); w1.z = cvt_pk_bf16(o1[4], o1[5]); w1.w = cvt_pk_bf16(o1[6], o1[7]);
            w2.x = cvt_pk_bf16(o2[0], o2[1]); w2.y = cvt_pk_bf16(o2[2], o2[3]); w2.z = cvt_pk_bf16(o2[4], o2[5]); w2.w = cvt_pk_bf16(o2[6], o2[7]);
            qf[kp] = __builtin_bit_cast(bf16x8, w1); qf[kp + 2] = __builtin_bit_cast(bf16x8, w2);
        }
        __syncthreads();
        f32x4 acc[8];
#pragma unroll
        for (int eb = 0; eb < 8; ++eb) acc[eb] = (f32x4){0.f, 0.f, 0.f, 0.f};
        if (n > 0) {
#pragma unroll
            for (int ks = 0; ks < 4; ++ks)
#pragma unroll
                for (int eb = 0; eb < 8; ++eb) { const bf16x8 a = *(const bf16x8*)(rts + (16 * eb + fr) * LP + 32 * ks + 8 * fq); acc[eb] = __builtin_amdgcn_mfma_f32_16x16x32_bf16(a, qf[ks], acc[eb], 0, 0, 0); }
            const float xi = exp2f((float)(il + 1) * log2g);
#pragma unroll
            for (int eb = 0; eb < 8; ++eb) acc[eb] *= xi;
        }
        for (int s = 0; s <= (w >> 1); ++s) {
            const int jb0 = 2 * s, jb1 = 2 * s + 1;
            f32x4 st0 = {0.f, 0.f, 0.f, 0.f}, st1 = {0.f, 0.f, 0.f, 0.f};
#pragma unroll
            for (int ks = 0; ks < 4; ++ks) { const bf16x8 a0 = *(const bf16x8*)(kn + (16 * jb0 + fr) * LP + 32 * ks + 8 * fq); st0 = __builtin_amdgcn_mfma_f32_16x16x32_bf16(a0, qf[ks], st0, 0, 0, 0); }
            if (jb1 <= w) {
#pragma unroll
                for (int ks = 0; ks < 4; ++ks) { const bf16x8 a1 = *(const bf16x8*)(kn + (16 * jb1 + fr) * LP + 32 * ks + 8 * fq); st1 = __builtin_amdgcn_mfma_f32_16x16x32_bf16(a1, qf[ks], st1, 0, 0, 0); }
            }
#pragma unroll
            for (int r = 0; r < 4; ++r) {
                const int d0 = il - (16 * jb0 + 4 * fq + r), d1 = il - (16 * jb1 + 4 * fq + r);
                st0[r] = d0 >= 0 ? st0[r] * exp2f((float)d0 * log2g) : 0.f;
                st1[r] = d1 >= 0 ? st1[r] * exp2f((float)d1 * log2g) : 0.f;
            }
            u32x4 sw; sw.x = cvt_pk_bf16(st0[0], st0[1]); sw.y = cvt_pk_bf16(st0[2], st0[3]); sw.z = cvt_pk_bf16(st1[0], st1[1]); sw.w = cvt_pk_bf16(st1[2], st1[3]);
            const bf16x8 sb = __builtin_bit_cast(bf16x8, sw);
            const unsigned va = lbase + (unsigned)(128 * LP * 2) + (unsigned)(((32 * s + 4 * fq + (fr >> 2)) * LP + 4 * (fr & 3)) * 2);
            u32x2 R[8][2];
            TR16(R, va, "4608");
#pragma unroll
            for (int eb = 0; eb < 8; ++eb) acc[eb] = __builtin_amdgcn_mfma_f32_16x16x32_bf16(cat8(R[eb][0], R[eb][1]), sb, acc[eb], 0, 0, 0);
        }
        float sm = 0.f;
#pragma unroll
        for (int eb = 0; eb < 8; ++eb) sm += (acc[eb][0] + acc[eb][1]) + (acc[eb][2] + acc[eb][3]);
        sm += __shfl_xor(sm, 16); sm += __shfl_xor(sm, 32);
        const float mu = sm * (1.0f / 128.0f);
        float qv = 0.f;
#pragma unroll
        for (int eb = 0; eb < 8; ++eb) { const f32x4 d = acc[eb] - mu; qv += (d[0] * d[0] + d[1] * d[1]) + (d[2] * d[2] + d[3] * d[3]); }
        qv += __shfl_xor(qv, 16); qv += __shfl_xor(qv, 32);
        const float rstd = rsqrtf(qv * (1.0f / 128.0f) + GN_EPS);
#pragma unroll
        for (int eb = 0; eb < 8; ++eb) {
            const int e0 = 16 * eb + 4 * fq;
            const f32x4 gw = gwv[eb];
            const float gv[4] = {bflo(gg[eb].x), bfhi(gg[eb].x), bflo(gg[eb].y), bfhi(gg[eb].y)};
            float y[4];
#pragma unroll
            for (int r = 0; r < 4; ++r) y[r] = (acc[eb][r] - mu) * rstd * gw[r] * gv[r] * sigmoidf_(gv[r]);
            u32x2 ow; ow.x = cvt_pk_bf16(y[0], y[1]); ow.y = cvt_pk_bf16(y[2], y[3]);
            *(u32x2*)(mix + t * DM + 1024 + h * 128 + e0) = ow;
        }
        __syncthreads();
    }
}
__device__ void ph_fixup(const Params& P) {
    const float* edge = (const float*)(P.ws + OFF_EDGE); bf16_t* act = (bf16_t*)(P.ws + OFF_ACT);
    for (int it = blockIdx.x * 512 + threadIdx.x; it < 256 * 1376; it += gridDim.x * 512) {
        const int fq4 = it % 1376, run = it / 1376;
        if ((run & 31) == 0) continue;
        const int f = 4 * fq4, pn = f >> 7, cf = f & 127, cg_ = pn * 256 + cf, cv_ = cg_ + 128;
        const float* e1 = edge + (size_t)run * 4 * UPC; const float* e0 = edge + (size_t)(run - 1) * 4 * UPC;
        const f32x4 Ga = *(const f32x4*)(e0 + 2 * UPC + cg_), Gb = *(const f32x4*)(e0 + 3 * UPC + cg_), Gc = *(const f32x4*)(e1 + cg_), Gd = *(const f32x4*)(e1 + UPC + cg_);
        const f32x4 Va = *(const f32x4*)(e0 + 2 * UPC + cv_), Vb = *(const f32x4*)(e0 + 3 * UPC + cv_), Vc = *(const f32x4*)(e1 + cv_), Vd = *(const f32x4*)(e1 + UPC + cv_);
        const float* cw = P.conv_w; const float* cb = P.conv_b;
        const f32x4 w0g = *(const f32x4*)(cw + f), w1g = *(const f32x4*)(cw + UPC + f), w2g = *(const f32x4*)(cw + 2 * UPC + f), bg = *(const f32x4*)(cb + f);
        const f32x4 w0v = *(const f32x4*)(cw + DFF + f), w1v = *(const f32x4*)(cw + UPC + DFF + f), w2v = *(const f32x4*)(cw + 2 * UPC + DFF + f), bv = *(const f32x4*)(cb + DFF + f);
        const f32x4 gate0 = bg + w2g * Gc + w1g * Gb + w0g * Ga, val0 = bv + w2v * Vc + w1v * Vb + w0v * Va;
        const f32x4 gate1 = bg + w2g * Gd + w1g * Gc + w0g * Gb, val1 = bv + w2v * Vd + w1v * Vc + w0v * Vb;
        f32x4 a0, a1;
#pragma unroll
        for (int j = 0; j < 4; ++j) { a0[j] = gate0[j] * sigmoidf_(gate0[j]) * val0[j]; a1[j] = gate1[j] * sigmoidf_(gate1[j]) * val1[j]; }
        u32x2 w0, w1; w0.x = cvt_pk_bf16(a0[0], a0[1]); w0.y = cvt_pk_bf16(a0[2], a0[3]); w1.x = cvt_pk_bf16(a1[0], a1[1]); w1.y = cvt_pk_bf16(a1[2], a1[3]);
        *(u32x2*)(act + (size_t)(run * 64) * DFF + f) = w0; *(u32x2*)(act + (size_t)(run * 64 + 1) * DFF + f) = w1;
    }
}
__device__ void ph_final(const Params& P) {
    const int lane = threadIdx.x & 63, gw = blockIdx.x * 8 + (threadIdx.x >> 6), nw = gridDim.x * 8;
    const float* ss4 = (const float*)(P.ws + OFF_SUMSQ) + 3 * NTOK; const bf16_t* h3b = (const bf16_t*)(P.ws + OFF_H3B);
    const f32x4* fw = (const f32x4*)P.final_norm_w;
    for (int row = gw; row < NTOK; row += 2 * nw) {
        const int row2 = row + nw; const bool has2 = row2 < NTOK;
        const u32x4* hi = (const u32x4*)(h3b + (size_t)row * DM); const u32x4* hj = (const u32x4*)(h3b + (size_t)(has2 ? row2 : row) * DM);
        u32x4 ha[4], hb[4];
#pragma unroll
        for (int i = 0; i < 4; ++i) { ha[i] = hi[i * 64 + lane]; hb[i] = hj[i * 64 + lane]; }
        const float rs = rsqrtf(ss4[row] * (1.0f / 2048.0f) + NORM_EPS), rs2 = rsqrtf(ss4[has2 ? row2 : row] * (1.0f / 2048.0f) + NORM_EPS);
        f32x4* o = (f32x4*)(P.out + (size_t)row * DM); f32x4* o2 = (f32x4*)(P.out + (size_t)row2 * DM);
#pragma unroll
        for (int i = 0; i < 4; ++i) { const int c = (i * 64 + lane) * 2; const f32x4 w0 = fw[c], w1 = fw[c + 1];
            o[c] = bf4lo(ha[i]) * rs * w0; o[c + 1] = bf4hi(ha[i]) * rs * w1;
            if (has2) { o2[c] = bf4lo(hb[i]) * rs2 * w0; o2[c + 1] = bf4hi(hb[i]) * rs2 * w1; } }
    }
}

#define XB_TMO      128
#define XB_XCNT(j)  (256  + 64 * (j))
#define XB_XSUB(j)  (1280 + 64 * (j))
#define XB_XGEN(j)  (2304 + 64 * (j))
#define XB_TOP      3328
#define XB_TOPGEN   3392
#define XCD_BAR_WORDS 3456
#define XB_SPIN_CAP (1u << 18)
__device__ __forceinline__ unsigned xb_ld(unsigned* p)              { return __hip_atomic_load(p, __ATOMIC_RELAXED, __HIP_MEMORY_SCOPE_AGENT); }
__device__ __forceinline__ unsigned xb_add(unsigned* p, unsigned v) { return __hip_atomic_fetch_add(p, v, __ATOMIC_RELAXED, __HIP_MEMORY_SCOPE_AGENT); }
__device__ __forceinline__ unsigned xb_xcc_id() { return (unsigned)__builtin_amdgcn_s_getreg((3 << 11) | 20) & 0xFu; }
#define XB_SPIN(cond, bar) do { unsigned _sp = 0; while (cond) { __builtin_amdgcn_s_sleep(1); \
    if ((++_sp & 255u) == 0u) { if (xb_ld(&(bar)[XB_TMO])) break; if (_sp > XB_SPIN_CAP) { atomicAdd(&(bar)[XB_TMO], 1u); break; } } } } while (0)
struct XcdBarrier { unsigned* bar; unsigned x; volatile LAS unsigned* st; };
__device__ __forceinline__ XcdBarrier xcd_barrier_post(unsigned* bar, volatile LAS unsigned* st) {
    XcdBarrier b; b.bar = bar; b.x = xb_xcc_id(); b.st = st;
    if (threadIdx.x == 0) (void)xb_add(&bar[XB_XCNT(b.x)], 1u);
    return b;
}
__device__ __forceinline__ void xcd_barrier_complete(unsigned* bar, unsigned x, unsigned& nloc, unsigned& nx) {
    const unsigned G = gridDim.x * gridDim.y * gridDim.z;
    unsigned sum, cnt, mine, sp = 0u;
    for (;;) {
        sum = 0u; cnt = 0u; mine = 0u;
#pragma unroll
        for (unsigned j = 0; j < 16; ++j) { const unsigned c = xb_ld(&bar[XB_XCNT(j)]); sum += c; cnt += (c > 0u) ? 1u : 0u; mine = (j == x) ? c : mine; }
        if (sum == G) break;
        __builtin_amdgcn_s_sleep(1);
        if ((++sp & 255u) == 0u) { if (xb_ld(&bar[XB_TMO])) break; if (sp > XB_SPIN_CAP) { atomicAdd(&bar[XB_TMO], 1u); break; } }
    }
    nloc = mine > 0u ? mine : 1u; nx = cnt > 0u ? cnt : 1u;
}
__device__ __forceinline__ void xcd_barrier(const XcdBarrier& b) {
    asm volatile("s_waitcnt vmcnt(0)" ::: "memory");
    __syncthreads();
    if (threadIdx.x == 0) {
        unsigned* bar = b.bar;
        __builtin_amdgcn_s_waitcnt(0);
        unsigned nloc = b.st[0], nx = b.st[1];
        if (nloc == 0u) { xcd_barrier_complete(bar, b.x, nloc, nx); b.st[0] = nloc; b.st[1] = nx; }
        const unsigned old = xb_add(&bar[XB_XSUB(b.x)], 1u);
        const unsigned gen = old / nloc;
        if (old + 1u == (gen + 1u) * nloc) {
            __builtin_amdgcn_fence(__ATOMIC_RELEASE, "agent");
            asm volatile("s_waitcnt vmcnt(0)" ::: "memory");
            const unsigned og = xb_add(&bar[XB_TOP], 1u);
            const unsigned tg = og / nx;
            if (og + 1u == (tg + 1u) * nx) xb_add(&bar[XB_TOPGEN], 1u);
            else XB_SPIN(xb_ld(&bar[XB_TOPGEN]) == tg, bar);
            __builtin_amdgcn_fence(__ATOMIC_ACQUIRE, "agent");
            xb_add(&bar[XB_XGEN(b.x)], 1u);
            asm volatile("s_waitcnt vmcnt(0)" ::: "memory");
        } else {
            XB_SPIN(xb_ld(&bar[XB_XGEN(b.x)]) == gen, bar);
            __builtin_amdgcn_fence(__ATOMIC_ACQUIRE, "agent");
            asm volatile("s_waitcnt vmcnt(0)" ::: "memory");
        }
    }
    __syncthreads();
}

__global__ void __launch_bounds__(512, 2) fwd_megakernel(const Params P) {
    extern __shared__ __attribute__((aligned(16))) unsigned char shm[];
    __shared__ uint4 xb_words;
    LAS unsigned char* lds = (LAS unsigned char*)shm;
    unsigned char* ws = P.ws;
    unsigned* xbar = (unsigned*)(ws + OFF_BAR);
    if (threadIdx.x == 0) xb_words = make_uint4(0u, 0u, 0u, 0u);
    __syncthreads();
    XcdBarrier xb = xcd_barrier_post(xbar, (volatile LAS unsigned*)&xb_words);
    float* ss = (float*)(ws + OFF_SUMSQ);
    pg8::StaticOrder S;
#define PH_ON(i) (P.ph_lo <= (i) && (i) < P.ph_hi)
#define PH_SYNC(i) if (P.ph_lo <= (i) && (i) + 1 < P.ph_hi) xcd_barrier(xb);
#if (PHMASK >> 0) & 1
    if (PH_ON(0)) ph_prologue(P, shm);
#endif
    PH_SYNC(0)
#if (PHMASK >> 1) & 1
    if (PH_ON(1)) { pg8::Gemm g{(const bf16_t*)(ws + OFF_XB), (const bf16_t*)(ws + OFF_WIN), NTOK, INC, DM, DM, DM, 0}; S.init(NTOK, INC, gridDim.x, blockIdx.x, 4);
        EpiScaleBf16 E{(bf16_t*)(ws + OFF_Z), INC, ss, nullptr}; pg8::gemm_phase(lds, g, S, E); }
#endif
    PH_SYNC(1)
#if (PHMASK >> 2) & 1
    if (PH_ON(2)) { const bool first = (blockIdx.x >> 3) & 1;
        if (first) wt_convert(P, shm, 2016, 3248);
        ph_pool_diff(P); ph_ret_kv(P, shm);
        if (!first) wt_convert(P, shm, 2016, 3248); }
#endif
    PH_SYNC(2)
#if (PHMASK >> 3) & 1
    if (PH_ON(3)) { pg8::Gemm g{(const bf16_t*)(ws + OFF_DIFF), (const bf16_t*)(ws + OFF_POOLT), NTOK, 1024, 256, 1024, 256, 512}; S.init(NTOK, 1024, gridDim.x, blockIdx.x);
        EpiScaleBf16 E{(bf16_t*)(ws + OFF_MIX), DM, nullptr, P.pool_scale}; pg8::gemm_phase(lds, g, S, E); ph_ret_scan(P); }
#endif
    PH_SYNC(3)
#if (PHMASK >> 4) & 1
    if (PH_ON(4)) { const bool first = (blockIdx.x >> 3) & 1;
        if (first) wt_convert(P, shm, 640, 2016);
        ph_ret_out(P, shm);
        if (!first) wt_convert(P, shm, 640, 2016); }
#endif
    PH_SYNC(4)
#if (PHMASK >> 5) & 1
    if (PH_ON(5)) { pg8::Gemm g{(const bf16_t*)(ws + OFF_MIX), (const bf16_t*)(ws + OFF_WOUT), NTOK, DM, DM, DM, DM, 0}; S.init(NTOK, DM, gridDim.x, blockIdx.x);
        EpiRes<false> E{ws + OFF_XB, (bf16_t*)(ws + OFF_H1B), ss + NTOK}; pg8::gemm_phase(lds, g, S, E); }
#endif
    PH_SYNC(5)
#if (PHMASK >> 6) & 1
    if (PH_ON(6)) { pg8::Gemm g{(const bf16_t*)(ws + OFF_H1B), (const bf16_t*)(ws + OFF_WUP), NTOK, UPC, DM, DM, DM, 0}; S.init(NTOK, UPC, gridDim.x, blockIdx.x, 4);
        EpiUp E{(bf16_t*)(ws + OFF_ACT), (float*)(ws + OFF_EDGE), ss + NTOK, P.conv_w, P.conv_b}; pg8::gemm_phase(lds, g, S, E); }
#endif
    PH_SYNC(6)
#if (PHMASK >> 7) & 1
    if (PH_ON(7)) ph_fixup(P);
#endif
    PH_SYNC(7)
#if (PHMASK >> 8) & 1
    if (PH_ON(8)) { pg8::Gemm g{(const bf16_t*)(ws + OFF_ACT), (const bf16_t*)(ws + OFF_WDOWN), NTOK, DM, DFF, DFF, DFF, 0}; S.init(NTOK, DM, gridDim.x, blockIdx.x);
        EpiRes<false> E{ws + OFF_H1B, (bf16_t*)(ws + OFF_H2B), ss + 2 * NTOK}; pg8::gemm_phase(lds, g, S, E); }
#endif
#if (PHMASK >> 11) & 1
    if (PH_ON(8)) { pg8::Gemm g2{(const bf16_t*)(ws + OFF_PB), (const bf16_t*)(ws + OFF_WPROJ), NTOK, DM, PLE, PLE, PLE, 0}; S.init(NTOK, DM, gridDim.x, blockIdx.x);
        EpiScaleBf16 E2{(bf16_t*)(ws + OFF_PROJ), DM, nullptr, nullptr}; pg8::gemm_phase(lds, g2, S, E2); }
#endif
    PH_SYNC(8)
#if (PHMASK >> 9) & 1
    if (PH_ON(9)) { pg8::Gemm g{(const bf16_t*)(ws + OFF_H2B), (const bf16_t*)(ws + OFF_WGATE), NTOK, DM, DM, DM, DM, 0}; S.init(NTOK, DM, gridDim.x, blockIdx.x);
        EpiGate E{(const bf16_t*)(ws + OFF_H2B), (bf16_t*)(ws + OFF_H3B), (const bf16_t*)(ws + OFF_PROJ), ss + 2 * NTOK, ss + 3 * NTOK}; pg8::gemm_phase(lds, g, S, E); }
#endif
    PH_SYNC(9)
#if (PHMASK >> 10) & 1
    if (PH_ON(10)) ph_final(P);
#endif
    if (P.ph_hi > 1000) cg::this_grid().sync();
}

constexpr int NPHASES = 11;

extern "C" void kernel_launch(void* const* d_in, const int* in_sizes, int n_in, void* d_out, int out_size, void* d_ws, size_t ws_size, hipStream_t stream) {
    (void)in_sizes; (void)n_in; (void)out_size; (void)ws_size;
    static int grid_blocks = 0;
    if (!grid_blocks) {
        (void)hipFuncSetAttribute((const void*)fwd_megakernel, hipFuncAttributeMaxDynamicSharedMemorySize, LDS_BYTES);
        int dev = 0, cus = 0, per_cu = 0;
        (void)hipGetDevice(&dev);
        (void)hipDeviceGetAttribute(&cus, hipDeviceAttributeMultiprocessorCount, dev);
        (void)hipOccupancyMaxActiveBlocksPerMultiprocessor(&per_cu, fwd_megakernel, 512, LDS_BYTES);
        if (per_cu < 1) per_cu = 1;
        if (per_cu > 1) per_cu = 1;
        grid_blocks = cus * per_cu;
    }
    Params P;
    memset(&P, 0, sizeof(P));
    P.x = (const float*)d_in[0]; P.p = (const float*)d_in[1]; P.norm1_w = (const float*)d_in[2]; P.w_in = (const float*)d_in[3];
    P.pool_w = (const float*)d_in[4]; P.pool_scale = (const float*)d_in[5]; P.ret_gn_w = (const float*)d_in[6]; P.w_out = (const float*)d_in[7];
    P.norm2_w = (const float*)d_in[8]; P.w_up = (const float*)d_in[9]; P.conv_w = (const float*)d_in[10]; P.conv_b = (const float*)d_in[11];
    P.w_down = (const float*)d_in[12]; P.norm3_w = (const float*)d_in[13]; P.ple_gate_w = (const float*)d_in[14]; P.ple_proj_w = (const float*)d_in[15];
    P.final_norm_w = (const float*)d_in[16];
    P.out = (float*)d_out; P.ws = (unsigned char*)d_ws;
    for (int i = 0; i < 64; ++i) { const float e = (float)(2 * i) / 128.0f; const float pw = powf(10000.0f, e); P.inv_freq[i] = 1.0f / pw; }
    for (int h = 0; h < 8; ++h) { const float gamma = 1.0f - exp2f(-5.0f - (float)h); P.log2g[h] = (float)std::log2((double)gamma); }
#if MK_SINGLE
    P.ph_lo = 0; P.ph_hi = NPHASES;
    void* args[] = {(void*)&P};
    (void)hipMemsetAsync((unsigned char*)d_ws + OFF_BAR, 0, XCD_BAR_WORDS * 4, stream);
    hipError_t e = hipLaunchCooperativeKernel((const void*)fwd_megakernel, dim3(grid_blocks), dim3(512), args, LDS_BYTES, stream);
    if (e != hipSuccess) fprintf(stderr, "cooperative launch failed: %s (grid %d)\n", hipGetErrorString(e), grid_blocks);
#else
    for (int ph = 0; ph < NPHASES; ++ph) {
        P.ph_lo = ph; P.ph_hi = ph + 1;
        hipLaunchKernelGGL(fwd_megakernel, dim3(grid_blocks), dim3(512), LDS_BYTES, stream, P);
    }
#endif
}
```

```cpp
#include <hip/hip_runtime.h>
#include <hip/hip_cooperative_groups.h>
#include <cmath>
#include <cstdio>
#include <cstring>
namespace cg = cooperative_groups;

#ifndef PHMASK
#define PHMASK 0xfff
#endif
#ifndef MK_SINGLE
#define MK_SINGLE 1
#endif

#define LAS __attribute__((address_space(3)))
typedef unsigned short bf16_t;
typedef short bf16x8 __attribute__((ext_vector_type(8)));
typedef float f32x4 __attribute__((ext_vector_type(4)));
typedef unsigned u32x4 __attribute__((ext_vector_type(4)));
typedef unsigned u32x2 __attribute__((ext_vector_type(2)));

constexpr int NTOK = 16384, DM = 2048, SEQ = 2048, INC = 5120, DFF = 5504, UPC = 11008, PLE = 256;
constexpr float NORM_EPS = 1e-6f, GN_EPS = 1e-5f;
constexpr size_t MiB = 1048576;
constexpr size_t OFF_WIN = 0, OFF_WPROJ = 20 * MiB, OFF_POOLT = 21 * MiB, OFF_WOUT = 22 * MiB, OFF_WUP = 30 * MiB,
                 OFF_WDOWN = 73 * MiB, OFF_WGATE = 95 * MiB, OFF_SUMSQ = 103 * MiB, OFF_COS = 103 * MiB + 262144,
                 OFF_SIN = OFF_COS + 524288, OFF_BAR = 104 * MiB + 524288, OFF_PB = 105 * MiB,
                 OFF_XB = 113 * MiB, OFF_Z = 177 * MiB, OFF_DIFF = 337 * MiB, OFF_KVT = 369 * MiB  , OFF_RT = 401 * MiB,
                 OFF_MIX = 433 * MiB, OFF_H1B = 177 * MiB, OFF_ACT = 241 * MiB, OFF_EDGE = 413 * MiB,
                 OFF_H2B = 113 * MiB, OFF_PROJ = 448 * MiB, OFF_H3B = 177 * MiB;
constexpr int LDS_BYTES = 131072 + 16384;
constexpr int EPI_LDS = 131072;

struct Params {
    const float *x, *p, *norm1_w, *w_in, *pool_w, *pool_scale, *ret_gn_w, *w_out, *norm2_w, *w_up, *conv_w, *conv_b, *w_down,
        *norm3_w, *ple_gate_w, *ple_proj_w, *final_norm_w;
    float* out;
    unsigned char* ws;
    float inv_freq[64];
    float log2g[8];
    int ph_lo, ph_hi;
};

typedef __bf16 bf16x2_t __attribute__((ext_vector_type(2)));
typedef float f32x2_t __attribute__((ext_vector_type(2)));
__device__ __forceinline__ unsigned cvt_pk_bf16(float lo, float hi) { const f32x2_t v = {lo, hi}; return __builtin_bit_cast(unsigned, __builtin_convertvector(v, bf16x2_t)); }
__device__ __forceinline__ float bflo(unsigned w) { return __uint_as_float(w << 16); }
__device__ __forceinline__ float bfhi(unsigned w) { return __uint_as_float(w & 0xffff0000u); }
__device__ __forceinline__ float sigmoidf_(float v) { return __builtin_amdgcn_rcpf(1.0f + __expf(-v)); }
template <int CTRL> __device__ __forceinline__ float dpp_f(float v) { return __builtin_bit_cast(float, __builtin_amdgcn_update_dpp(0, __builtin_bit_cast(int, v), CTRL, 0xf, 0xf, true)); }
template <int CTRL> __device__ __forceinline__ float dpp_o(float old, float v) { return __builtin_bit_cast(float, __builtin_amdgcn_update_dpp(__builtin_bit_cast(int, old), __builtin_bit_cast(int, v), CTRL, 0xf, 0xf, false)); }
__device__ __forceinline__ float wave_sum(float s) {
    s += __shfl_xor(s, 32); s += __shfl_xor(s, 16); s += __shfl_xor(s, 8); s += __shfl_xor(s, 4); s += __shfl_xor(s, 2); s += __shfl_xor(s, 1); return s;
}

namespace pg8 {
constexpr int BM = 256, BK = 64, HALF = 128, HTB = HALF * BK * 2, NXCD = 8, WGM = 8;
__device__ __forceinline__ int lds_byte(int r, int c) { const int st = (r >> 4) * 2 + (c >> 5), rr = r & 15, cc = c & 31, ob = rr * 64 + cc * 2; return st * 1024 + (ob ^ (((ob >> 9) & 1) << 5)); }
__device__ __forceinline__ void stage_rc(int b, int& R, int& C) { const int st = b / 1024, sb = b % 1024, swz = sb ^ (((sb >> 9) & 1) << 5); R = (st >> 1) * 16 + swz / 64; C = (st & 1) * 32 + (swz % 64) / 2; }
__device__ __forceinline__ int perm32(int rho) { const int n = rho >> 4, i = rho & 15; return 8 * (i >> 2) + 4 * n + (i & 3); }

struct Unit { int pm, pn; };
struct Gemm { const bf16_t* A; const bf16_t* Bt; int M, N, K, lda, ldb, a_pn_off; };

struct StaticOrder {
    int nM, nN, nwg, G, c;
    __device__ void init(int M, int N, int G_, int c_) { nM = M / BM; nN = N / BM; nwg = nM * nN; G = G_; c = c_; }
    __device__ bool next(int i, Unit& u) const {
        const long L = (long)i * G + c; if (L >= nwg) return false;
        int wgid = (int)L; { const int q = nwg / NXCD, r = nwg % NXCD, xcd = wgid % NXCD, off = wgid / NXCD; wgid = (xcd < r ? xcd * (q + 1) : r * (q + 1) + (xcd - r) * q) + off; }
        const int nig = WGM * nN, gid = wgid / nig, fm = gid * WGM, gsz = (nM - fm) < WGM ? (nM - fm) : WGM;
        u.pm = fm + ((wgid % nig) % gsz); u.pn = (wgid % nig) / gsz; return true;
    }
};

template <class Epi>
__device__ __forceinline__ void gemm_phase(LAS unsigned char* lds, const Gemm g, const StaticOrder& S, const Epi& E) {
    int tid_ = threadIdx.x; asm volatile("" : "+v"(tid_));
    const int tid = tid_, wid = __builtin_amdgcn_readfirstlane(tid >> 6), lane = tid & 63, wr = wid >> 2, wc = wid & 3, fr = lane & 15, fq = lane >> 4;
    const int K = g.K, nt = K / BK;
    unsigned voffA[2], voffB[2];
#pragma unroll
    for (int i = 0; i < 2; ++i) { int R, C; stage_rc(tid * 16 + i * 8192, R, C); const int Rb = (R & ~31) + perm32(R & 31);
        voffA[i] = (unsigned)(R * g.lda + C) * 2u; voffB[i] = (unsigned)(Rb * g.ldb + C) * 2u; }
    const size_t kstep = (size_t)(BK * 2);
    const size_t hstepA = (size_t)HALF * g.lda * 2, hstepB = (size_t)HALF * g.ldb * 2;
    const size_t tstepA = 2 * hstepA, tstepB = 2 * hstepB;
    const unsigned ldsw = (unsigned)wid * 1024u;
    const int aoff = lds_byte(wr * 64 + fr, fq * 8), boff = lds_byte(wc * 32 + fr, fq * 8);
#define PG8_SA(b, h) (((b) * 2 + (h)) * HTB)
#define PG8_SB(b, h) ((4 + (b) * 2 + (h)) * HTB)
#define PG8_STAGE(bufoff, gbase, voff) do { _Pragma("unroll") for (int _i = 0; _i < 2; ++_i) \
        __builtin_amdgcn_global_load_lds((const unsigned*)((const char*)(gbase) + (voff)[_i]), (LAS unsigned*)(lds + (bufoff) + ldsw + _i * 8192), 16, 0, 0); } while (0)
#define PG8_LDA(dst, b, h) do { _Pragma("unroll") for (int m = 0; m < 4; ++m) _Pragma("unroll") for (int k = 0; k < 2; ++k) dst[m][k] = *(const LAS bf16x8*)(lds + PG8_SA(b, h) + aoff + m * 2048 + k * 1024); } while (0)
#define PG8_LDB(dst, b, h) do { _Pragma("unroll") for (int n = 0; n < 2; ++n) _Pragma("unroll") for (int k = 0; k < 2; ++k) dst[n][k] = *(const LAS bf16x8*)(lds + PG8_SB(b, h) + boff + n * 2048 + k * 1024); } while (0)
#define PG8_MMA(ai, bj, At, Bt) do { __builtin_amdgcn_s_setprio(1); _Pragma("unroll") for (int m = 0; m < 4; ++m) _Pragma("unroll") for (int n = 0; n < 2; ++n) _Pragma("unroll") for (int k = 0; k < 2; ++k) \
        acc[ai][bj][m][n] = __builtin_amdgcn_mfma_f32_16x16x32_bf16(Bt[n][k], At[m][k], acc[ai][bj][m][n], 0, 0, 0); __builtin_amdgcn_s_setprio(0); } while (0)
#define PG8_WAIT_V(n) asm volatile("s_waitcnt vmcnt(" #n ")" ::: "memory")
#define PG8_WAIT_L(n) asm volatile("s_waitcnt lgkmcnt(" #n ")" ::: "memory")
#define PG8_BAR __builtin_amdgcn_s_barrier()
#define PG8_SCHED __builtin_amdgcn_sched_barrier(0)
    Unit cur, nxt; int ui = 0, ubuf = 0;
    if (!S.next(0, cur)) return;
    E.prefetch(lds, cur, ubuf, wid, lane);
    f32x4 acc[2][2][4][2];
#pragma unroll
    for (int a = 0; a < 2; ++a)
#pragma unroll
        for (int b = 0; b < 2; ++b)
#pragma unroll
            for (int m = 0; m < 4; ++m)
#pragma unroll
                for (int n = 0; n < 2; ++n) acc[a][b][m][n] = (f32x4){0.f, 0.f, 0.f, 0.f};
    bf16x8 At[4][2], B0[2][2], B1[2][2];
    const char* cA = (const char*)g.A + (size_t)cur.pm * tstepA + (size_t)cur.pn * g.a_pn_off; const char* cB = (const char*)g.Bt + (size_t)cur.pn * tstepB;
    PG8_STAGE(PG8_SB(0, 0), cB, voffB); PG8_STAGE(PG8_SA(0, 0), cA, voffA); PG8_STAGE(PG8_SB(0, 1), cB + hstepB, voffB); PG8_STAGE(PG8_SA(0, 1), cA + hstepA, voffA);
    if (wr == 1) PG8_BAR;
    PG8_WAIT_V(4); PG8_BAR;
    PG8_STAGE(PG8_SB(1, 0), cB + kstep, voffB); PG8_STAGE(PG8_SA(1, 0), cA + kstep, voffA); PG8_STAGE(PG8_SB(1, 1), cB + hstepB + kstep, voffB);
    PG8_WAIT_V(6); PG8_BAR;
    for (;;) {
        const bool has_next = S.next(ui + 1, nxt);
        const char* nA = has_next ? (const char*)g.A + (size_t)nxt.pm * tstepA + (size_t)nxt.pn * g.a_pn_off : cA; const char* nB = has_next ? (const char*)g.Bt + (size_t)nxt.pn * tstepB : cB;
        for (int t = 0; t < nt; t += 2) {
            const bool last = (t == nt - 2);
            const char* a1 = cA + (size_t)(t + 1) * kstep;
            const char* a2 = last ? nA : cA + (size_t)(t + 2) * kstep; const char* b2 = last ? nB : cB + (size_t)(t + 2) * kstep;
            const char* a3 = a2 + kstep; const char* b3 = b2 + kstep;
            PG8_LDB(B0, 0, 0); PG8_SCHED; PG8_LDA(At, 0, 0); PG8_STAGE(PG8_SA(1, 1), a1 + hstepA, voffA);
            PG8_WAIT_L(8); PG8_BAR; PG8_WAIT_L(0); PG8_MMA(0, 0, At, B0); PG8_BAR; PG8_SCHED;
            PG8_LDB(B1, 0, 1); PG8_STAGE(PG8_SB(0, 0), b2, voffB);
            PG8_BAR; PG8_WAIT_L(0); PG8_MMA(0, 1, At, B1); PG8_BAR;
            PG8_LDA(At, 0, 1); PG8_STAGE(PG8_SA(0, 0), a2, voffA);
            PG8_BAR; PG8_WAIT_L(0); PG8_MMA(1, 0, At, B0); PG8_BAR; PG8_SCHED;
            PG8_STAGE(PG8_SB(0, 1), b2 + hstepB, voffB);
            PG8_WAIT_V(6); PG8_BAR; PG8_MMA(1, 1, At, B1); PG8_BAR;
            PG8_LDB(B0, 1, 0); PG8_SCHED; PG8_LDA(At, 1, 0); PG8_STAGE(PG8_SA(0, 1), a2 + hstepA, voffA);
            PG8_WAIT_L(8); PG8_BAR; PG8_WAIT_L(0); PG8_MMA(0, 0, At, B0); PG8_BAR; PG8_SCHED;
            PG8_LDB(B1, 1, 1); PG8_STAGE(PG8_SB(1, 0), b3, voffB);
            PG8_BAR; PG8_WAIT_L(0); PG8_MMA(0, 1, At, B1); PG8_BAR;
            PG8_LDA(At, 1, 1); PG8_STAGE(PG8_SA(1, 0), a3, voffA);
            PG8_BAR; PG8_WAIT_L(0); PG8_MMA(1, 0, At, B0); PG8_BAR; PG8_SCHED;
            PG8_STAGE(PG8_SB(1, 1), b3 + hstepB, voffB);
            PG8_WAIT_V(6); PG8_BAR; PG8_MMA(1, 1, At, B1); PG8_BAR;
        }
        E(acc, cur, wr, wc, fr, fq, lds, ubuf);
        if (!has_next) break;
        ubuf ^= 1; E.prefetch(lds, nxt, ubuf, wid, lane);
#pragma unroll
        for (int a = 0; a < 2; ++a)
#pragma unroll
            for (int b = 0; b < 2; ++b)
#pragma unroll
                for (int m = 0; m < 4; ++m)
#pragma unroll
                    for (int n = 0; n < 2; ++n) acc[a][b][m][n] = (f32x4){0.f, 0.f, 0.f, 0.f};
        cur = nxt; cA = nA; cB = nB; ++ui;
    }
    PG8_WAIT_V(0);
    if (wr == 0) PG8_BAR;
    PG8_BAR;
#undef PG8_SA
#undef PG8_SB
#undef PG8_STAGE
#undef PG8_LDA
#undef PG8_LDB
#undef PG8_MMA
#undef PG8_WAIT_V
#undef PG8_WAIT_L
#undef PG8_BAR
#undef PG8_SCHED
}
}
using pg8::Unit;

__device__ __forceinline__ f32x4 bf4lo(const u32x4 w) { return (f32x4){bflo(w.x), bfhi(w.x), bflo(w.y), bfhi(w.y)}; }
__device__ __forceinline__ f32x4 bf4hi(const u32x4 w) { return (f32x4){bflo(w.z), bfhi(w.z), bflo(w.w), bfhi(w.w)}; }
__device__ __forceinline__ u32x4 pack8(const f32x4 v0, const f32x4 v1) { u32x4 w; w.x = cvt_pk_bf16(v0[0], v0[1]); w.y = cvt_pk_bf16(v0[2], v0[3]); w.z = cvt_pk_bf16(v1[0], v1[1]); w.w = cvt_pk_bf16(v1[2], v1[3]); return w; }
__device__ __forceinline__ float sq8(const f32x4 v0, const f32x4 v1) { return v0[0] * v0[0] + v0[1] * v0[1] + v0[2] * v0[2] + v0[3] * v0[3] + v1[0] * v1[0] + v1[1] * v1[1] + v1[2] * v1[2] + v1[3] * v1[3]; }
struct EpiScaleBf16 {
    bf16_t* O; int ldc; const float* ss; const float* cscale;
    __device__ __forceinline__ void prefetch(LAS unsigned char*, const Unit&, int, int, int) const {}
    __device__ __forceinline__ void operator()(const f32x4 (&acc)[2][2][4][2], const Unit& u, int wr, int wc, int fr, int fq, LAS unsigned char* lds, int ubuf) const {
        const int row0 = u.pm * 256 + wr * 64 + fr, col0 = u.pn * 256 + wc * 32 + 8 * fq;
        f32x4 cs[2][2]; float rsv[2][4];
#pragma unroll
        for (int bj = 0; bj < 2; ++bj)
#pragma unroll
            for (int n = 0; n < 2; ++n) cs[bj][n] = cscale ? *(const f32x4*)(cscale + col0 + bj * 128 + 4 * n) : (f32x4){1.f, 1.f, 1.f, 1.f};
#pragma unroll
        for (int ai = 0; ai < 2; ++ai)
#pragma unroll
            for (int m = 0; m < 4; ++m) rsv[ai][m] = ss ? ss[row0 + ai * 128 + m * 16] : 0.f;
        __builtin_amdgcn_sched_barrier(0);
#pragma unroll
        for (int ai = 0; ai < 2; ++ai)
#pragma unroll
            for (int m = 0; m < 4; ++m) {
                const int row = row0 + ai * 128 + m * 16;
                const float rs = ss ? rsqrtf(rsv[ai][m] * (1.0f / 2048.0f) + NORM_EPS) : 1.0f;
                bf16_t* rowp = O + (size_t)row * ldc + col0;
#pragma unroll
                for (int bj = 0; bj < 2; ++bj) *(u32x4*)(rowp + bj * 128) = pack8(acc[ai][bj][m][0] * rs * cs[bj][0], acc[ai][bj][m][1] * rs * cs[bj][1]);
            }
    }
};
template <bool RF32> struct EpiRes {
    const void* res; bf16_t* ob; float* ssq;
    __device__ __forceinline__ void prefetch(LAS unsigned char*, const Unit&, int, int, int) const {}
    __device__ __forceinline__ void operator()(const f32x4 (&acc)[2][2][4][2], const Unit& u, int wr, int wc, int fr, int fq, LAS unsigned char* lds, int ubuf) const {
        const int row0 = u.pm * 256 + wr * 64 + fr, col0 = u.pn * 256 + wc * 32 + 8 * fq;
        if constexpr (RF32) {
#pragma unroll
            for (int ai = 0; ai < 2; ++ai) {
                f32x4 r0[4][2], r1[4][2];
#pragma unroll
                for (int m = 0; m < 4; ++m)
#pragma unroll
                    for (int bj = 0; bj < 2; ++bj) {
                        const size_t o = (size_t)(row0 + ai * 128 + m * 16) * DM + col0 + bj * 128;
                        r0[m][bj] = *(const f32x4*)((const float*)res + o); r1[m][bj] = *(const f32x4*)((const float*)res + o + 4);
                    }
                __builtin_amdgcn_sched_barrier(0);
#pragma unroll
                for (int m = 0; m < 4; ++m) {
                    const int row = row0 + ai * 128 + m * 16;
                    float s = 0.f;
#pragma unroll
                    for (int bj = 0; bj < 2; ++bj) {
                        const size_t o = (size_t)row * DM + col0 + bj * 128;
                        const f32x4 v0 = acc[ai][bj][m][0] + r0[m][bj], v1 = acc[ai][bj][m][1] + r1[m][bj];
                        *(u32x4*)(ob + o) = pack8(v0, v1);
                        s += sq8(v0, v1);
                    }
                    s += __shfl_xor(s, 16); s += __shfl_xor(s, 32);
                    if (fq == 0) unsafeAtomicAdd(ssq + row, s);
                }
            }
        } else {
            u32x4 pw[2][4][2];
#pragma unroll
            for (int ai = 0; ai < 2; ++ai)
#pragma unroll
                for (int m = 0; m < 4; ++m)
#pragma unroll
                    for (int bj = 0; bj < 2; ++bj) pw[ai][m][bj] = *(const u32x4*)((const bf16_t*)res + (size_t)(row0 + ai * 128 + m * 16) * DM + col0 + bj * 128);
            __builtin_amdgcn_sched_barrier(0);
#pragma unroll
            for (int ai = 0; ai < 2; ++ai)
#pragma unroll
                for (int m = 0; m < 4; ++m) {
                    const int row = row0 + ai * 128 + m * 16;
                    float s = 0.f;
#pragma unroll
                    for (int bj = 0; bj < 2; ++bj) {
                        const size_t o = (size_t)row * DM + col0 + bj * 128;
                        const f32x4 v0 = acc[ai][bj][m][0] + bf4lo(pw[ai][m][bj]), v1 = acc[ai][bj][m][1] + bf4hi(pw[ai][m][bj]);
                        *(u32x4*)(ob + o) = pack8(v0, v1);
                        s += sq8(v0, v1);
                    }
                    s += __shfl_xor(s, 16); s += __shfl_xor(s, 32);
                    if (fq == 0) unsafeAtomicAdd(ssq + row, s);
                }
        }
    }
};
struct EpiGate {
    const bf16_t* h2b; bf16_t* h3b; const bf16_t* proj; const float* ss3; float* ss4;
    __device__ __forceinline__ void prefetch(LAS unsigned char*, const Unit&, int, int, int) const {}
    __device__ __forceinline__ void operator()(const f32x4 (&acc)[2][2][4][2], const Unit& u, int wr, int wc, int fr, int fq, LAS unsigned char* lds, int ubuf) const {
        const int row0 = u.pm * 256 + wr * 64 + fr, col0 = u.pn * 256 + wc * 32 + 8 * fq;
#pragma unroll
        for (int ai = 0; ai < 2; ++ai) {
            u32x4 hw[4][2], pw[4][2]; float rsv[4];
#pragma unroll
            for (int m = 0; m < 4; ++m) {
                rsv[m] = ss3[row0 + ai * 128 + m * 16];
#pragma unroll
                for (int bj = 0; bj < 2; ++bj) {
                    const size_t o = (size_t)(row0 + ai * 128 + m * 16) * DM + col0 + bj * 128;
                    hw[m][bj] = *(const u32x4*)(h2b + o); pw[m][bj] = *(const u32x4*)(proj + o);
                }
            }
            __builtin_amdgcn_sched_barrier(0);
#pragma unroll
            for (int m = 0; m < 4; ++m) {
                const int row = row0 + ai * 128 + m * 16;
                const float rs = rsqrtf(rsv[m] * (1.0f / 2048.0f) + NORM_EPS);
                float s = 0.f;
#pragma unroll
                for (int bj = 0; bj < 2; ++bj) {
                    const size_t o = (size_t)row * DM + col0 + bj * 128;
                    const f32x4 r0 = bf4lo(hw[m][bj]), r1 = bf4hi(hw[m][bj]), p0 = bf4lo(pw[m][bj]), p1 = bf4hi(pw[m][bj]);
                    f32x4 v0, v1;
#pragma unroll
                    for (int j = 0; j < 4; ++j) { v0[j] = r0[j] + sigmoidf_(acc[ai][bj][m][0][j] * rs) * p0[j]; v1[j] = r1[j] + sigmoidf_(acc[ai][bj][m][1][j] * rs) * p1[j]; }
                    *(u32x4*)(h3b + o) = pack8(v0, v1);
                    s += sq8(v0, v1);
                }
                s += __shfl_xor(s, 16); s += __shfl_xor(s, 32);
                if (fq == 0) unsafeAtomicAdd(ss4 + row, s);
            }
        }
    }
};
struct EpiUp {
    bf16_t* act; float* edge; const float* ss2; const float* conv_w; const float* conv_b;
    __device__ __forceinline__ void prefetch(LAS unsigned char* lds, const Unit& u, int ubuf, int wid, int lane) const {
        if (wid < 5) {
            const int p = wid * 64 + lane, a = p >> 5, wi = p & 31;
            const float* src;
            if (a < 8) { const int par = a & 3, f = (a >> 2) * DFF + u.pn * 128 + 4 * wi; src = (par < 3) ? conv_w + par * UPC + f : conv_b + f; }
            else src = ss2 + u.pm * 256 + (p - 256) * 4;
            __builtin_amdgcn_global_load_lds((const unsigned*)src, (LAS unsigned*)(lds + EPI_LDS + ubuf * 8192 + wid * 1024), 16, 0, 0);
        }
    }
    __device__ __forceinline__ void operator()(const f32x4 (&acc)[2][2][4][2], const Unit& u, int wr, int wc, int fr, int fq, LAS unsigned char* lds, int ubuf) const {
        const LAS float* pp = (const LAS float*)(lds + EPI_LDS + ubuf * 8192);
        float rsv[2][4];
#pragma unroll
        for (int ai = 0; ai < 2; ++ai)
#pragma unroll
            for (int m = 0; m < 4; ++m) rsv[ai][m] = rsqrtf(pp[1024 + ai * 128 + wr * 64 + m * 16 + fr] * (1.0f / 2048.0f) + NORM_EPS);
#pragma unroll
        for (int n = 0; n < 2; ++n) {
            const int cf = wc * 32 + 8 * fq + 4 * n;
            const int f = u.pn * 128 + cf;
            const f32x4 w0g = *(const LAS f32x4*)(pp + cf), w1g = *(const LAS f32x4*)(pp + 128 + cf), w2g = *(const LAS f32x4*)(pp + 256 + cf), bg = *(const LAS f32x4*)(pp + 384 + cf);
            const f32x4 w0v = *(const LAS f32x4*)(pp + 512 + cf), w1v = *(const LAS f32x4*)(pp + 640 + cf), w2v = *(const LAS f32x4*)(pp + 768 + cf), bv = *(const LAS f32x4*)(pp + 896 + cf);
#pragma unroll
            for (int ai = 0; ai < 2; ++ai) {
                const int run = u.pm * 4 + ai * 2 + wr;
                float* eg = edge + (size_t)run * 4 * UPC + u.pn * 256 + cf;
                f32x4 pG = {0.f, 0.f, 0.f, 0.f}, pV = {0.f, 0.f, 0.f, 0.f};
#pragma unroll
                for (int m = 0; m < 4; ++m) {
                    const int row = run * 64 + m * 16 + fr;
                    const float rs = rsv[ai][m];
                    const f32x4 G = acc[ai][0][m][n] * rs, V = acc[ai][1][m][n] * rs;
                    if (m == 0 && fr < 2) { *(f32x4*)(eg + (size_t)fr * UPC) = G; *(f32x4*)(eg + (size_t)fr * UPC + 128) = V; }
                    if (m == 3 && fr >= 14) { *(f32x4*)(eg + (size_t)(fr - 12) * UPC) = G; *(f32x4*)(eg + (size_t)(fr - 12) * UPC + 128) = V; }
                    f32x4 g1, g2, v1, v2;
#pragma unroll
                    for (int j = 0; j < 4; ++j) {
                        g1[j] = dpp_o<0x111>(dpp_f<0x10F>(pG[j]), G[j]); g2[j] = dpp_o<0x112>(dpp_f<0x10E>(pG[j]), G[j]);
                        v1[j] = dpp_o<0x111>(dpp_f<0x10F>(pV[j]), V[j]); v2[j] = dpp_o<0x112>(dpp_f<0x10E>(pV[j]), V[j]);
                    }
                    const f32x4 gate = bg + w2g * G + w1g * g1 + w0g * g2;
                    const f32x4 val = bv + w2v * V + w1v * v1 + w0v * v2;
                    f32x4 a;
#pragma unroll
                    for (int j = 0; j < 4; ++j) a[j] = gate[j] * sigmoidf_(gate[j]) * val[j];
                    u32x2 w; w.x = cvt_pk_bf16(a[0], a[1]); w.y = cvt_pk_bf16(a[2], a[3]);
                    *(u32x2*)(act + (size_t)row * DFF + f) = w;
                    pG = G; pV = V;
                }
            }
        }
    }
};

struct WtJob { const float* W; const float* scale; bf16_t* Bt; int ldw, ldb, k0, n0, up; };
__device__ __forceinline__ bool wt_job(const Params& P, int id, WtJob& j) {
    unsigned char* ws = P.ws;
    const int T0 = 640, T1 = T0 + 1376, T2 = T1 + 688, T3 = T2 + 256, T4 = T3 + 256, T5 = T4 + 32, T6 = T5 + 16;
    if (id >= T6) return false;
    j.up = 0;
    if (id < T0) { const int nt = id % 20, kt = id / 20; j = WtJob{P.w_in, P.norm1_w, (bf16_t*)(ws + OFF_WIN), INC, DM, kt * 64, nt * 256, 0}; }
    else if (id < T1) { const int l = id - T0, nt = l % 43, kt = l / 43; j = WtJob{P.w_up, P.norm2_w, (bf16_t*)(ws + OFF_WUP), UPC, DM, kt * 64, nt * 256, 1}; }
    else if (id < T2) { const int l = id - T1, nt = l % 8, kt = l / 8; j = WtJob{P.w_down, nullptr, (bf16_t*)(ws + OFF_WDOWN), DM, DFF, kt * 64, nt * 256, 0}; }
    else if (id < T3) { const int l = id - T2, nt = l % 8, kt = l / 8; j = WtJob{P.w_out, nullptr, (bf16_t*)(ws + OFF_WOUT), DM, DM, kt * 64, nt * 256, 0}; }
    else if (id < T4) { const int l = id - T3, nt = l % 8, kt = l / 8; j = WtJob{P.ple_gate_w, P.norm3_w, (bf16_t*)(ws + OFF_WGATE), DM, DM, kt * 64, nt * 256, 0}; }
    else if (id < T5) { const int l = id - T4, nt = l % 8, kt = l / 8; j = WtJob{P.ple_proj_w, nullptr, (bf16_t*)(ws + OFF_WPROJ), DM, PLE, kt * 64, nt * 256, 0}; }
    else { const int l = id - T5, g = l >> 2, kt = l & 3; j = WtJob{P.pool_w + g * 65536, nullptr, (bf16_t*)(ws + OFF_POOLT) + g * 65536, 256, 256, kt * 64, 0, 0}; }
    return true;
}
__device__ __forceinline__ void wt_load(const WtJob& j, f32x4 (&v)[8]) {
    const int c4 = (threadIdx.x & 63) * 4, r = threadIdx.x >> 6;
#pragma unroll
    for (int i = 0; i < 8; ++i) v[i] = *(const f32x4*)(j.W + (size_t)(j.k0 + r + 8 * i) * j.ldw + j.n0 + c4);
}
__device__ __forceinline__ void wt_put(const WtJob& j, const f32x4 (&v)[8], float* tile) {
    const int c4 = (threadIdx.x & 63) * 4, r = threadIdx.x >> 6;
#pragma unroll
    for (int i = 0; i < 8; ++i) { const int k = r + 8 * i; const float sc = j.scale ? j.scale[j.k0 + k] : 1.0f; *(f32x4*)(tile + k * 260 + (c4 ^ (4 * i))) = v[i] * sc; }
}
__device__ __forceinline__ void wt_store(const WtJob& j, const float* tile) {
#pragma unroll
    for (int it = 0; it < 4; ++it) {
        const int item = threadIdx.x + 512 * it, n = item >> 3, ko = item & 7; float v[8];
#pragma unroll
        for (int i = 0; i < 8; ++i) v[i] = tile[(ko * 8 + i) * 260 + (n ^ (4 * ko))];
        int nn = j.n0 + n;
        if (j.up) { const int half = nn >= DFF ? 1 : 0, f = nn - half * DFF; nn = 256 * (f >> 7) + 128 * half + (f & 127); }
        u32x4 w; w.x = cvt_pk_bf16(v[0], v[1]); w.y = cvt_pk_bf16(v[2], v[3]); w.z = cvt_pk_bf16(v[4], v[5]); w.w = cvt_pk_bf16(v[6], v[7]);
        *(u32x4*)(j.Bt + (size_t)nn * j.ldb + j.k0 + ko * 8) = w;
    }
}

__device__ void wt_convert(const Params& P, unsigned char* shm, int lo, int hi) {
    float* tile = (float*)shm; WtJob cur, nxt; f32x4 v[8];
    int id = lo + blockIdx.x; bool have = id < hi && wt_job(P, id, cur);
    if (have) wt_load(cur, v);
    while (have) {
        wt_put(cur, v, tile);
        __syncthreads();
        id += gridDim.x; const bool hn = id < hi && wt_job(P, id, nxt);
        if (hn) wt_load(nxt, v);
        wt_store(cur, tile);
        __syncthreads();
        cur = nxt; have = hn;
    }
}
__device__ void ph_prologue(const Params& P, unsigned char* shm) {
    const int tid = threadIdx.x, lane = tid & 63, wid = tid >> 6;
    const int gw = blockIdx.x * 8 + wid, nw = gridDim.x * 8;
    const int gt = blockIdx.x * 512 + tid, ntot = gridDim.x * 512;
    unsigned char* ws = P.ws;
    { bf16_t* xb = (bf16_t*)(ws + OFF_XB); float* ss1 = (float*)(ws + OFF_SUMSQ);
      for (int row = gw; row < NTOK; row += nw) {
          const f32x4* src = (const f32x4*)(P.x + (size_t)row * DM); u32x2* dst = (u32x2*)(xb + (size_t)row * DM); float s = 0.f;
#pragma unroll
          for (int i = 0; i < 8; ++i) { const f32x4 v = src[i * 64 + lane]; s += v[0] * v[0] + v[1] * v[1] + v[2] * v[2] + v[3] * v[3];
              u32x2 w; w.x = cvt_pk_bf16(v[0], v[1]); w.y = cvt_pk_bf16(v[2], v[3]); dst[i * 64 + lane] = w; }
          s = wave_sum(s); if (lane == 0) ss1[row] = s; } }
    { const f32x4* src = (const f32x4*)P.p; u32x2* dst = (u32x2*)(ws + OFF_PB);
      for (int i = gt; i < NTOK * PLE / 4; i += 4 * ntot) {
          f32x4 v[4];
#pragma unroll
          for (int k = 0; k < 4; ++k) { const int j = i + k * ntot; v[k] = src[j < NTOK * PLE / 4 ? j : i]; }
#pragma unroll
          for (int k = 0; k < 4; ++k) { const int j = i + k * ntot; u32x2 w; w.x = cvt_pk_bf16(v[k][0], v[k][1]); w.y = cvt_pk_bf16(v[k][2], v[k][3]); if (j < NTOK * PLE / 4) dst[j] = w; } } }
    { float* ss = (float*)(ws + OFF_SUMSQ) + NTOK; for (int i = gt; i < 3 * NTOK; i += ntot) ss[i] = 0.f; }
    { float* ct = (float*)(ws + OFF_COS); float* st = (float*)(ws + OFF_SIN);
      for (int i = gt; i < SEQ * 64; i += ntot) { const int pos = i >> 6, fi = i & 63; const float ang = (float)pos * P.inv_freq[fi];
          double rev = (double)ang * 0.15915494309189533577; rev -= rint(rev); const float rv = (float)rev;
          ct[i] = __builtin_amdgcn_cosf(rv); st[i] = __builtin_amdgcn_sinf(rv); } }
    wt_convert(P, shm, 0, 640);
    wt_convert(P, shm, 3248, 3264);
}

__device__ __forceinline__ void bf8_acc(float (&s)[8], const u32x4 v, float sg) {
    s[0] += sg * bflo(v.x); s[1] += sg * bfhi(v.x); s[2] += sg * bflo(v.y); s[3] += sg * bfhi(v.y); s[4] += sg * bflo(v.z); s[5] += sg * bfhi(v.z); s[6] += sg * bflo(v.w); s[7] += sg * bfhi(v.w);
}
__device__ void ph_pool_diff(const Params& P) {
    const bf16_t* __restrict__ z = (const bf16_t*)(P.ws + OFF_Z); bf16_t* __restrict__ diff = (bf16_t*)(P.ws + OFF_DIFF);
    for (int it = blockIdx.x * 512 + threadIdx.x; it < 1024 * 128; it += gridDim.x * 512) {
        const int strip = it >> 7, oc = it & 127; const int R0 = strip * 16, s0 = R0 & (SEQ - 1); const int w = 2 << (oc >> 5);
        const bf16_t* zc = z + 8 * oc;
        float s[8];
#pragma unroll
        for (int i = 0; i < 8; ++i) s[i] = 0.f;
        if (s0 > 0) {
            u32x4 pv[16];
#pragma unroll
            for (int d = 1; d <= 16; ++d) pv[d - 1] = (d <= w) ? *(const u32x4*)(zc + (size_t)(R0 - d) * INC) : (u32x4){0u, 0u, 0u, 0u};
#pragma unroll
            for (int d = 1; d <= 16; ++d) bf8_acc(s, pv[d - 1], 1.0f);
        }
#pragma unroll
        for (int half = 0; half < 2; ++half) {
            u32x4 cu[8], od[8];
#pragma unroll
            for (int r = 0; r < 8; ++r) { const int rr = half * 8 + r; cu[r] = *(const u32x4*)(zc + (size_t)(R0 + rr) * INC);
                od[r] = (s0 + rr - w >= 0) ? *(const u32x4*)(zc + (size_t)(R0 + rr - w) * INC) : (u32x4){0u, 0u, 0u, 0u}; }
#pragma unroll
            for (int r = 0; r < 8; ++r) {
                const int rr = half * 8 + r, t = s0 + rr;
                bf8_acc(s, cu[r], 1.0f); bf8_acc(s, od[r], -1.0f);
                const float inv = 1.0f / (float)(t + 1 < w ? t + 1 : w);
                const u32x4 v = cu[r];
                u32x4 ow; ow.x = cvt_pk_bf16(s[0] * inv - bflo(v.x), s[1] * inv - bfhi(v.x)); ow.y = cvt_pk_bf16(s[2] * inv - bflo(v.y), s[3] * inv - bfhi(v.y));
                ow.z = cvt_pk_bf16(s[4] * inv - bflo(v.z), s[5] * inv - bfhi(v.z)); ow.w = cvt_pk_bf16(s[6] * inv - bflo(v.w), s[7] * inv - bfhi(v.w));
                *(u32x4*)(diff + (size_t)(R0 + rr) * 1024 + 8 * oc) = ow;
            }
        }
    }
}

constexpr int LP = 144;
struct KRaw { u32x4 a, c; f32x4 c0, c1, s0, s1; };
__device__ __forceinline__ void k_load(const bf16_t* z, const float* cosT, const float* sinT, int b, int h, int n, int it, KRaw& r) {
    const int j = it >> 3, o = it & 7, pos = n * 128 + j; const size_t t = (size_t)b * SEQ + pos;
    const bf16_t* kp = z + t * INC + 2048 + h * 128 + 8 * o;
    r.a = *(const u32x4*)kp; r.c = *(const u32x4*)(kp + 64);
    r.c0 = *(const f32x4*)(cosT + pos * 64 + 8 * o); r.c1 = *(const f32x4*)(cosT + pos * 64 + 8 * o + 4);
    r.s0 = *(const f32x4*)(sinT + pos * 64 + 8 * o); r.s1 = *(const f32x4*)(sinT + pos * 64 + 8 * o + 4);
}
template <bool TR, bool ZETA = TR> __device__ __forceinline__ void k_put(const KRaw& r, int it, float log2g, bf16_t* dst) {
    const int j = it >> 3, o = it & 7;
    const float sc = 0.08838834764831845f * (ZETA ? exp2f((float)(127 - j) * log2g) : 1.0f);
    const float x1[8] = {bflo(r.a.x), bfhi(r.a.x), bflo(r.a.y), bfhi(r.a.y), bflo(r.a.z), bfhi(r.a.z), bflo(r.a.w), bfhi(r.a.w)};
    const float x2[8] = {bflo(r.c.x), bfhi(r.c.x), bflo(r.c.y), bfhi(r.c.y), bflo(r.c.z), bfhi(r.c.z), bflo(r.c.w), bfhi(r.c.w)};
    const float cc[8] = {r.c0[0], r.c0[1], r.c0[2], r.c0[3], r.c1[0], r.c1[1], r.c1[2], r.c1[3]}, ss[8] = {r.s0[0], r.s0[1], r.s0[2], r.s0[3], r.s1[0], r.s1[1], r.s1[2], r.s1[3]};
    float o1[8], o2[8];
#pragma unroll
    for (int i = 0; i < 8; ++i) { o1[i] = (x1[i] * cc[i] - x2[i] * ss[i]) * sc; o2[i] = (x2[i] * cc[i] + x1[i] * ss[i]) * sc; }
    if (TR) {
#pragma unroll
        for (int i = 0; i < 8; ++i) { const unsigned pk = cvt_pk_bf16(o1[i], o2[i]); dst[(8 * o + i) * LP + j] = (bf16_t)(pk & 0xffffu); dst[(64 + 8 * o + i) * LP + j] = (bf16_t)(pk >> 16); }
    } else {
        u32x4 w1, w2; w1.x = cvt_pk_bf16(o1[0], o1[1]); w1.y = cvt_pk_bf16(o1[2], o1[3]); w1.z = cvt_pk_bf16(o1[4], o1[5]); w1.w = cvt_pk_bf16(o1[6], o1[7]);
        w2.x = cvt_pk_bf16(o2[0], o2[1]); w2.y = cvt_pk_bf16(o2[2], o2[3]); w2.z = cvt_pk_bf16(o2[4], o2[5]); w2.w = cvt_pk_bf16(o2[6], o2[7]);
        *(u32x4*)(dst + j * LP + 8 * o) = w1; *(u32x4*)(dst + j * LP + 64 + 8 * o) = w2;
    }
}
__device__ __forceinline__ u32x4 v_load(const bf16_t* z, int b, int h, int n, int it) {
    const int j = it >> 4, o = it & 15; const size_t t = (size_t)b * SEQ + n * 128 + j;
    return *(const u32x4*)(z + t * INC + 3072 + h * 128 + 8 * o);
}
__device__ __forceinline__ void v_put(const u32x4 v, int it, bf16_t* dst) {
    const int j = it >> 4, o = it & 15; const unsigned w[4] = {v.x, v.y, v.z, v.w};
#pragma unroll
    for (int i = 0; i < 4; ++i) { dst[(8 * o + 2 * i) * LP + j] = (bf16_t)(w[i] & 0xffffu); dst[(8 * o + 2 * i + 1) * LP + j] = (bf16_t)(w[i] >> 16); }
}

__device__ __forceinline__ void v_put_nat(const u32x4 v, int it, bf16_t* dst) { *(u32x4*)(dst + (it >> 4) * LP + (it & 15) * 8) = v; }
#define TRD(i, off) "ds_read_b64_tr_b16 %" #i ", %16 offset:" off "\n\t"
#define TR16(R, ADDR, S2) asm volatile( \
    TRD(0, "0") TRD(1, S2) TRD(2, "32") TRD(3, "32+" S2) TRD(4, "64") TRD(5, "64+" S2) TRD(6, "96") TRD(7, "96+" S2) \
    TRD(8, "128") TRD(9, "128+" S2) TRD(10, "160") TRD(11, "160+" S2) TRD(12, "192") TRD(13, "192+" S2) TRD(14, "224") TRD(15, "224+" S2) \
    "s_waitcnt lgkmcnt(0)" \
    : "=&v"(R[0][0]), "=&v"(R[0][1]), "=&v"(R[1][0]), "=&v"(R[1][1]), "=&v"(R[2][0]), "=&v"(R[2][1]), "=&v"(R[3][0]), "=&v"(R[3][1]), \
      "=&v"(R[4][0]), "=&v"(R[4][1]), "=&v"(R[5][0]), "=&v"(R[5][1]), "=&v"(R[6][0]), "=&v"(R[6][1]), "=&v"(R[7][0]), "=&v"(R[7][1]) \
    : "v"(ADDR) : "memory")
__device__ __forceinline__ bf16x8 cat8(const u32x2 lo, const u32x2 hi) { u32x4 w; w.x = lo.x; w.y = lo.y; w.z = hi.x; w.w = hi.y; return __builtin_bit_cast(bf16x8, w); }

__device__ void ph_ret_kv(const Params& P, unsigned char* shm) {
    const bf16_t* z = (const bf16_t*)(P.ws + OFF_Z); const float* cosT = (const float*)(P.ws + OFF_COS); const float* sinT = (const float*)(P.ws + OFF_SIN);
    bf16_t* kvT = (bf16_t*)(P.ws + OFF_KVT);
    bf16_t* kn = (bf16_t*)shm; bf16_t* vn = kn + 128 * LP;
    const int tid = threadIdx.x, w = __builtin_amdgcn_readfirstlane(tid >> 6), lane = tid & 63, fr = lane & 15, fq = lane >> 4;
    const unsigned lbase = (unsigned)(size_t)(LAS unsigned char*)shm;
    const unsigned tro = (unsigned)(((8 * fq + (fr >> 2)) * LP + 4 * (fr & 3)) * 2);
    KRaw kr[2]; u32x4 vr[4];
    int ui = blockIdx.x;
    if (ui < 960) { const int bh = ui / 15, n = ui - bh * 15, h = bh & 7, b = bh >> 3;
#pragma unroll
        for (int i = 0; i < 4; ++i) vr[i] = v_load(z, b, h, n, tid + 512 * i);
#pragma unroll
        for (int i = 0; i < 2; ++i) k_load(z, cosT, sinT, b, h, n, tid + 512 * i, kr[i]); }
    for (; ui < 960; ui += gridDim.x) {
        const int bh = ui / 15, n = ui - bh * 15, h = bh & 7, unit = bh * 16 + n;
#pragma unroll
        for (int i = 0; i < 4; ++i) v_put_nat(vr[i], tid + 512 * i, vn);
#pragma unroll
        for (int i = 0; i < 2; ++i) k_put<false, true>(kr[i], tid + 512 * i, P.log2g[h], kn);
        __syncthreads();
        { const int un = ui + gridDim.x;
          if (un < 960) { const int bh2 = un / 15, n2 = un - bh2 * 15, h2 = bh2 & 7, b2 = bh2 >> 3;
#pragma unroll
              for (int i = 0; i < 4; ++i) vr[i] = v_load(z, b2, h2, n2, tid + 512 * i);
#pragma unroll
              for (int i = 0; i < 2; ++i) k_load(z, cosT, sinT, b2, h2, n2, tid + 512 * i, kr[i]); } }
        f32x4 acc[8];
#pragma unroll
        for (int eb = 0; eb < 8; ++eb) acc[eb] = (f32x4){0.f, 0.f, 0.f, 0.f};
#pragma unroll
        for (int ks = 0; ks < 4; ++ks) {
            const unsigned ka = lbase + tro + (unsigned)(ks * 32 * LP * 2 + 16 * w * 2);
            u32x2 a0, a1;
            asm volatile("ds_read_b64_tr_b16 %0, %2\n\tds_read_b64_tr_b16 %1, %2 offset:1152\n\ts_waitcnt lgkmcnt(0)" : "=&v"(a0), "=&v"(a1) : "v"(ka) : "memory");
            const bf16x8 a = cat8(a0, a1);
            const unsigned va = lbase + (unsigned)(128 * LP * 2) + tro + (unsigned)(ks * 32 * LP * 2);
            u32x2 R[8][2];
            TR16(R, va, "1152");
#pragma unroll
            for (int eb = 0; eb < 8; ++eb) acc[eb] = __builtin_amdgcn_mfma_f32_16x16x32_bf16(a, cat8(R[eb][0], R[eb][1]), acc[eb], 0, 0, 0);
        }
        bf16_t* dst = kvT + (size_t)unit * 16384;
#pragma unroll
        for (int eb = 0; eb < 8; ++eb) { u32x2 kw; kw.x = cvt_pk_bf16(acc[eb][0], acc[eb][1]); kw.y = cvt_pk_bf16(acc[eb][2], acc[eb][3]); *(u32x2*)(dst + (16 * eb + fr) * 128 + 16 * w + 4 * fq) = kw; }
        __syncthreads();
    }
}
__device__ void ph_ret_scan(const Params& P) {
    const bf16_t* kvT = (const bf16_t*)(P.ws + OFF_KVT); bf16_t* RT = (bf16_t*)(P.ws + OFF_RT);
    for (int it = blockIdx.x * 512 + threadIdx.x; it < 64 * 4096; it += gridDim.x * 512) {
        const int bh = it >> 12, q4 = it & 4095; const float gc = exp2f(128.0f * P.log2g[bh & 7]);
        const size_t o0 = ((size_t)(bh * 16)) * 16384 + 4 * q4;
        u32x2 kv[15];
#pragma unroll
        for (int n = 0; n < 15; ++n) kv[n] = *(const u32x2*)(kvT + o0 + (size_t)n * 16384);
        f32x4 R = {0.f, 0.f, 0.f, 0.f};
#pragma unroll
        for (int n = 0; n < 16; ++n) {
            u32x2 w; w.x = cvt_pk_bf16(R[0], R[1]); w.y = cvt_pk_bf16(R[2], R[3]); *(u32x2*)(RT + o0 + (size_t)n * 16384) = w;
            if (n < 15) R = R * gc + (f32x4){bflo(kv[n].x), bfhi(kv[n].x), bflo(kv[n].y), bfhi(kv[n].y)};
        }
    }
}
__device__ void ph_ret_out(const Params& P, unsigned char* shm) {
    const bf16_t* z = (const bf16_t*)(P.ws + OFF_Z); const float* cosT = (const float*)(P.ws + OFF_COS); const float* sinT = (const float*)(P.ws + OFF_SIN);
    const bf16_t* RT = (const bf16_t*)(P.ws + OFF_RT); bf16_t* mix = (bf16_t*)(P.ws + OFF_MIX);
    bf16_t* kn = (bf16_t*)shm; bf16_t* vn = kn + 128 * LP; bf16_t* rts = vn + 128 * LP;
    const unsigned lbase = (unsigned)(size_t)(LAS unsigned char*)shm;
    const int tid = threadIdx.x, w = __builtin_amdgcn_readfirstlane(tid >> 6), lane = tid & 63, fr = lane & 15, fq = lane >> 4;
    for (int unit = blockIdx.x; unit < 1024; unit += gridDim.x) {
        const int n = unit & 15, h = (unit >> 4) & 7, b = unit >> 7; const float log2g = P.log2g[h];
        const int il = 16 * w + fr, pos = n * 128 + il; const size_t t = (size_t)b * SEQ + pos;
        KRaw kr[2]; u32x4 vr[4], rr[4]; KRaw qr[2]; u32x2 gg[8];
#pragma unroll
        for (int i = 0; i < 4; ++i) vr[i] = v_load(z, b, h, n, tid + 512 * i);
#pragma unroll
        for (int i = 0; i < 2; ++i) k_load(z, cosT, sinT, b, h, n, tid + 512 * i, kr[i]);
        if (n > 0) {
#pragma unroll
            for (int i = 0; i < 4; ++i) { const int it = tid + 512 * i; rr[i] = *(const u32x4*)(RT + (size_t)unit * 16384 + (it >> 4) * 128 + (it & 15) * 8); }
        }
#pragma unroll
        for (int kp = 0; kp < 2; ++kp) {
            const int d0 = 8 * fq + 32 * kp; const bf16_t* qp = z + t * INC + 1024 + h * 128 + d0;
            qr[kp].a = *(const u32x4*)qp; qr[kp].c = *(const u32x4*)(qp + 64);
            qr[kp].c0 = *(const f32x4*)(cosT + pos * 64 + d0); qr[kp].c1 = *(const f32x4*)(cosT + pos * 64 + d0 + 4);
            qr[kp].s0 = *(const f32x4*)(sinT + pos * 64 + d0); qr[kp].s1 = *(const f32x4*)(sinT + pos * 64 + d0 + 4);
        }
#pragma unroll
        for (int eb = 0; eb < 8; ++eb) gg[eb] = *(const u32x2*)(z + t * INC + 4096 + h * 128 + 16 * eb + 4 * fq);
        f32x4 gwv[8];
#pragma unroll
        for (int eb = 0; eb < 8; ++eb) gwv[eb] = *(const f32x4*)(P.ret_gn_w + h * 128 + 16 * eb + 4 * fq);
        __builtin_amdgcn_sched_barrier(0);
#pragma unroll
        for (int i = 0; i < 4; ++i) v_put_nat(vr[i], tid + 512 * i, vn);
#pragma unroll
        for (int i = 0; i < 2; ++i) k_put<false>(kr[i], tid + 512 * i, log2g, kn);
        if (n > 0) {
#pragma unroll
            for (int i = 0; i < 4; ++i) { const int it = tid + 512 * i; *(u32x4*)(rts + (it >> 4) * LP + (it & 15) * 8) = rr[i]; }
        }
        bf16x8 qf[4];
#pragma unroll
        for (int kp = 0; kp < 2; ++kp) {
            const u32x4 a = qr[kp].a, c = qr[kp].c;
            const float x1[8] = {bflo(a.x), bfhi(a.x), bflo(a.y), bfhi(a.y), bflo(a.z), bfhi(a.z), bflo(a.w), bfhi(a.w)};
            const float x2[8] = {bflo(c.x), bfhi(c.x), bflo(c.y), bfhi(c.y), bflo(c.z), bfhi(c.z), bflo(c.w), bfhi(c.w)};
            const float cc[8] = {qr[kp].c0[0], qr[kp].c0[1], qr[kp].c0[2], qr[kp].c0[3], qr[kp].c1[0], qr[kp].c1[1], qr[kp].c1[2], qr[kp].c1[3]};
            const float ss[8] = {qr[kp].s0[0], qr[kp].s0[1], qr[kp].s0[2], qr[kp].s0[3], qr[kp].s1[0], qr[kp].s1[1], qr[kp].s1[2], qr[kp].s1[3]};
            float o1[8], o2[8];
#pragma unroll
            for (int i = 0; i < 8; ++i) { o1[i] = x1[i] * cc[i] - x2[i] * ss[i]; o2[i] = x2[i] * cc[i] + x1[i] * ss[i]; }
            u32x4 w1, w2; w1.x = cvt_pk_bf16(o1[0], o1[1]); w1.y = cvt_pk_bf16(o1[2], o1[3]); w1.z = cvt_pk_bf16(o1[4], o1[5]); w1.w = cvt_pk_bf16(o1[6], o1[7]);
            w2.x = cvt_pk_bf16(o2[0], o2[1]); w2.y = cvt_pk_bf16(o2[2], o2[3]); w2.z = cvt_pk_bf16(o2[4], o2[5]); w2.w = cvt_pk_bf16(o2[6], o2[7]);
            qf[kp] = __builtin_bit_cast(bf16x8, w1); qf[kp + 2] = __builtin_bit_cast(bf16x8, w2);
        }
        __syncthreads();
        f32x4 acc[8];
#pragma unroll
        for (int eb = 0; eb < 8; ++eb) acc[eb] = (f32x4){0.f, 0.f, 0.f, 0.f};
        if (n > 0) {
#pragma unroll
            for (int ks = 0; ks < 4; ++ks)
#pragma unroll
                for (int eb = 0; eb < 8; ++eb) { const bf16x8 a = *(const bf16x8*)(rts + (16 * eb + fr) * LP + 32 * ks + 8 * fq); acc[eb] = __builtin_amdgcn_mfma_f32_16x16x32_bf16(a, qf[ks], acc[eb], 0, 0, 0); }
            const float xi = exp2f((float)(il + 1) * log2g);
#pragma unroll
            for (int eb = 0; eb < 8; ++eb) acc[eb] *= xi;
        }
        for (int s = 0; s <= (w >> 1); ++s) {
            const int jb0 = 2 * s, jb1 = 2 * s + 1;
            f32x4 st0 = {0.f, 0.f, 0.f, 0.f}, st1 = {0.f, 0.f, 0.f, 0.f};
#pragma unroll
            for (int ks = 0; ks < 4; ++ks) { const bf16x8 a0 = *(const bf16x8*)(kn + (16 * jb0 + fr) * LP + 32 * ks + 8 * fq); st0 = __builtin_amdgcn_mfma_f32_16x16x32_bf16(a0, qf[ks], st0, 0, 0, 0); }
            if (jb1 <= w) {
#pragma unroll
                for (int ks = 0; ks < 4; ++ks) { const bf16x8 a1 = *(const bf16x8*)(kn + (16 * jb1 + fr) * LP + 32 * ks + 8 * fq); st1 = __builtin_amdgcn_mfma_f32_16x16x32_bf16(a1, qf[ks], st1, 0, 0, 0); }
            }
#pragma unroll
            for (int r = 0; r < 4; ++r) {
                const int d0 = il - (16 * jb0 + 4 * fq + r), d1 = il - (16 * jb1 + 4 * fq + r);
                st0[r] = d0 >= 0 ? st0[r] * exp2f((float)d0 * log2g) : 0.f;
                st1[r] = d1 >= 0 ? st1[r] * exp2f((float)d1 * log2g) : 0.f;
            }
            u32x4 sw; sw.x = cvt_pk_bf16(st0[0], st0[1]); sw.y = cvt_pk_bf16(st0[2], st0[3]); sw.z = cvt_pk_bf16(st1[0], st1[1]); sw.w = cvt_pk_bf16(st1[2], st1[3]);
            const bf16x8 sb = __builtin_bit_cast(bf16x8, sw);
            const unsigned va = lbase + (unsigned)(128 * LP * 2) + (unsigned)(((32 * s + 4 * fq + (fr >> 2)) * LP + 4 * (fr & 3)) * 2);
            u32x2 R[8][2];
            TR16(R, va, "4608");
#pragma unroll
            for (int eb = 0; eb < 8; ++eb) acc[eb] = __builtin_amdgcn_mfma_f32_16x16x32_bf16(cat8(R[eb][0], R[eb][1]), sb, acc[eb], 0, 0, 0);
        }
        float sm = 0.f;
#pragma unroll
        for (int eb = 0; eb < 8; ++eb) sm += (acc[eb][0] + acc[eb][1]) + (acc[eb][2] + acc[eb][3]);
        sm += __shfl_xor(sm, 16); sm += __shfl_xor(sm, 32);
        const float mu = sm * (1.0f / 128.0f);
        float qv = 0.f;
#pragma unroll
        for (int eb = 0; eb < 8; ++eb) { const f32x4 d = acc[eb] - mu; qv += (d[0] * d[0] + d[1] * d[1]) + (d[2] * d[2] + d[3] * d[3]); }
        qv += __shfl_xor(qv, 16); qv += __shfl_xor(qv, 32);
        const float rstd = rsqrtf(qv * (1.0f / 128.0f) + GN_EPS);
#pragma unroll
        for (int eb = 0; eb < 8; ++eb) {
            const int e0 = 16 * eb + 4 * fq;
            const f32x4 gw = gwv[eb];
            const float gv[4] = {bflo(gg[eb].x), bfhi(gg[eb].x), bflo(gg[eb].y), bfhi(gg[eb].y)};
            float y[4];
#pragma unroll
            for (int r = 0; r < 4; ++r) y[r] = (acc[eb][r] - mu) * rstd * gw[r] * gv[r] * sigmoidf_(gv[r]);
            u32x2 ow; ow.x = cvt_pk_bf16(y[0], y[1]); ow.y = cvt_pk_bf16(y[2], y[3]);
            *(u32x2*)(mix + t * DM + 1024 + h * 128 + e0) = ow;
        }
        __syncthreads();
    }
}
__device__ void ph_fixup(const Params& P) {
    const float* edge = (const float*)(P.ws + OFF_EDGE); bf16_t* act = (bf16_t*)(P.ws + OFF_ACT);
    for (int it = blockIdx.x * 512 + threadIdx.x; it < 256 * 1376; it += gridDim.x * 512) {
        const int fq4 = it % 1376, run = it / 1376;
        if ((run & 31) == 0) continue;
        const int f = 4 * fq4, pn = f >> 7, cf = f & 127, cg_ = pn * 256 + cf, cv_ = cg_ + 128;
        const float* e1 = edge + (size_t)run * 4 * UPC; const float* e0 = edge + (size_t)(run - 1) * 4 * UPC;
        const f32x4 Ga = *(const f32x4*)(e0 + 2 * UPC + cg_), Gb = *(const f32x4*)(e0 + 3 * UPC + cg_), Gc = *(const f32x4*)(e1 + cg_), Gd = *(const f32x4*)(e1 + UPC + cg_);
        const f32x4 Va = *(const f32x4*)(e0 + 2 * UPC + cv_), Vb = *(const f32x4*)(e0 + 3 * UPC + cv_), Vc = *(const f32x4*)(e1 + cv_), Vd = *(const f32x4*)(e1 + UPC + cv_);
        const float* cw = P.conv_w; const float* cb = P.conv_b;
        const f32x4 w0g = *(const f32x4*)(cw + f), w1g = *(const f32x4*)(cw + UPC + f), w2g = *(const f32x4*)(cw + 2 * UPC + f), bg = *(const f32x4*)(cb + f);
        const f32x4 w0v = *(const f32x4*)(cw + DFF + f), w1v = *(const f32x4*)(cw + UPC + DFF + f), w2v = *(const f32x4*)(cw + 2 * UPC + DFF + f), bv = *(const f32x4*)(cb + DFF + f);
        const f32x4 gate0 = bg + w2g * Gc + w1g * Gb + w0g * Ga, val0 = bv + w2v * Vc + w1v * Vb + w0v * Va;
        const f32x4 gate1 = bg + w2g * Gd + w1g * Gc + w0g * Gb, val1 = bv + w2v * Vd + w1v * Vc + w0v * Vb;
        f32x4 a0, a1;
#pragma unroll
        for (int j = 0; j < 4; ++j) { a0[j] = gate0[j] * sigmoidf_(gate0[j]) * val0[j]; a1[j] = gate1[j] * sigmoidf_(gate1[j]) * val1[j]; }
        u32x2 w0, w1; w0.x = cvt_pk_bf16(a0[0], a0[1]); w0.y = cvt_pk_bf16(a0[2], a0[3]); w1.x = cvt_pk_bf16(a1[0], a1[1]); w1.y = cvt_pk_bf16(a1[2], a1[3]);
        *(u32x2*)(act + (size_t)(run * 64) * DFF + f) = w0; *(u32x2*)(act + (size_t)(run * 64 + 1) * DFF + f) = w1;
    }
}
__device__ void ph_final(const Params& P) {
    const int lane = threadIdx.x & 63, gw = blockIdx.x * 8 + (threadIdx.x >> 6), nw = gridDim.x * 8;
    const float* ss4 = (const float*)(P.ws + OFF_SUMSQ) + 3 * NTOK; const bf16_t* h3b = (const bf16_t*)(P.ws + OFF_H3B);
    const f32x4* fw = (const f32x4*)P.final_norm_w;
    for (int row = gw; row < NTOK; row += 2 * nw) {
        const int row2 = row + nw; const bool has2 = row2 < NTOK;
        const u32x4* hi = (const u32x4*)(h3b + (size_t)row * DM); const u32x4* hj = (const u32x4*)(h3b + (size_t)(has2 ? row2 : row) * DM);
        u32x4 ha[4], hb[4];
#pragma unroll
        for (int i = 0; i < 4; ++i) { ha[i] = hi[i * 64 + lane]; hb[i] = hj[i * 64 + lane]; }
        const float rs = rsqrtf(ss4[row] * (1.0f / 2048.0f) + NORM_EPS), rs2 = rsqrtf(ss4[has2 ? row2 : row] * (1.0f / 2048.0f) + NORM_EPS);
        f32x4* o = (f32x4*)(P.out + (size_t)row * DM); f32x4* o2 = (f32x4*)(P.out + (size_t)row2 * DM);
#pragma unroll
        for (int i = 0; i < 4; ++i) { const int c = (i * 64 + lane) * 2; const f32x4 w0 = fw[c], w1 = fw[c + 1];
            o[c] = bf4lo(ha[i]) * rs * w0; o[c + 1] = bf4hi(ha[i]) * rs * w1;
            if (has2) { o2[c] = bf4lo(hb[i]) * rs2 * w0; o2[c + 1] = bf4hi(hb[i]) * rs2 * w1; } }
    }
}

#define XB_TMO      128
#define XB_XCNT(j)  (256  + 64 * (j))
#define XB_XSUB(j)  (1280 + 64 * (j))
#define XB_XGEN(j)  (2304 + 64 * (j))
#define XB_TOP      3328
#define XB_TOPGEN   3392
#define XCD_BAR_WORDS 3456
#define XB_SPIN_CAP (1u << 18)
__device__ __forceinline__ unsigned xb_ld(unsigned* p)              { return __hip_atomic_load(p, __ATOMIC_RELAXED, __HIP_MEMORY_SCOPE_AGENT); }
__device__ __forceinline__ unsigned xb_add(unsigned* p, unsigned v) { return __hip_atomic_fetch_add(p, v, __ATOMIC_RELAXED, __HIP_MEMORY_SCOPE_AGENT); }
__device__ __forceinline__ unsigned xb_xcc_id() { return (unsigned)__builtin_amdgcn_s_getreg((3 << 11) | 20) & 0xFu; }
#define XB_SPIN(cond, bar) do { unsigned _sp = 0; while (cond) { __builtin_amdgcn_s_sleep(1); \
    if ((++_sp & 255u) == 0u) { if (xb_ld(&(bar)[XB_TMO])) break; if (_sp > XB_SPIN_CAP) { atomicAdd(&(bar)[XB_TMO], 1u); break; } } } } while (0)
struct XcdBarrier { unsigned* bar; unsigned x; volatile LAS unsigned* st; };
__device__ __forceinline__ XcdBarrier xcd_barrier_post(unsigned* bar, volatile LAS unsigned* st) {
    XcdBarrier b; b.bar = bar; b.x = xb_xcc_id(); b.st = st;
    if (threadIdx.x == 0) (void)xb_add(&bar[XB_XCNT(b.x)], 1u);
    return b;
}
__device__ __forceinline__ void xcd_barrier_complete(unsigned* bar, unsigned x, unsigned& nloc, unsigned& nx) {
    const unsigned G = gridDim.x * gridDim.y * gridDim.z;
    unsigned sum, cnt, mine, sp = 0u;
    for (;;) {
        sum = 0u; cnt = 0u; mine = 0u;
#pragma unroll
        for (unsigned j = 0; j < 16; ++j) { const unsigned c = xb_ld(&bar[XB_XCNT(j)]); sum += c; cnt += (c > 0u) ? 1u : 0u; mine = (j == x) ? c : mine; }
        if (sum == G) break;
        __builtin_amdgcn_s_sleep(1);
        if ((++sp & 255u) == 0u) { if (xb_ld(&bar[XB_TMO])) break; if (sp > XB_SPIN_CAP) { atomicAdd(&bar[XB_TMO], 1u); break; } }
    }
    nloc = mine > 0u ? mine : 1u; nx = cnt > 0u ? cnt : 1u;
}
__device__ __forceinline__ void xcd_barrier(const XcdBarrier& b) {
    asm volatile("s_waitcnt vmcnt(0)" ::: "memory");
    __syncthreads();
    if (threadIdx.x == 0) {
        unsigned* bar = b.bar;
        __builtin_amdgcn_s_waitcnt(0);
        unsigned nloc = b.st[0], nx = b.st[1];
        if (nloc == 0u) { xcd_barrier_complete(bar, b.x, nloc, nx); b.st[0] = nloc; b.st[1] = nx; }
        const unsigned old = xb_add(&bar[XB_XSUB(b.x)], 1u);
        const unsigned gen = old / nloc;
        if (old + 1u == (gen + 1u) * nloc) {
            __builtin_amdgcn_fence(__ATOMIC_RELEASE, "agent");
            asm volatile("s_waitcnt vmcnt(0)" ::: "memory");
            const unsigned og = xb_add(&bar[XB_TOP], 1u);
            const unsigned tg = og / nx;
            if (og + 1u == (tg + 1u) * nx) xb_add(&bar[XB_TOPGEN], 1u);
            else XB_SPIN(xb_ld(&bar[XB_TOPGEN]) == tg, bar);
            __builtin_amdgcn_fence(__ATOMIC_ACQUIRE, "agent");
            xb_add(&bar[XB_XGEN(b.x)], 1u);
            asm volatile("s_waitcnt vmcnt(0)" ::: "memory");
        } else {
            XB_SPIN(xb_ld(&bar[XB_XGEN(b.x)]) == gen, bar);
            __builtin_amdgcn_fence(__ATOMIC_ACQUIRE, "agent");
            asm volatile("s_waitcnt vmcnt(0)" ::: "memory");
        }
    }
    __syncthreads();
}

__global__ void __launch_bounds__(512, 2) fwd_megakernel(const Params P) {
    extern __shared__ __attribute__((aligned(16))) unsigned char shm[];
    __shared__ uint4 xb_words;
    LAS unsigned char* lds = (LAS unsigned char*)shm;
    unsigned char* ws = P.ws;
    unsigned* xbar = (unsigned*)(ws + OFF_BAR);
    if (threadIdx.x == 0) xb_words = make_uint4(0u, 0u, 0u, 0u);
    __syncthreads();
    XcdBarrier xb = xcd_barrier_post(xbar, (volatile LAS unsigned*)&xb_words);
    float* ss = (float*)(ws + OFF_SUMSQ);
    pg8::StaticOrder S;
#define PH_ON(i) (P.ph_lo <= (i) && (i) < P.ph_hi)
#define PH_SYNC(i) if (P.ph_lo <= (i) && (i) + 1 < P.ph_hi) xcd_barrier(xb);
#if (PHMASK >> 0) & 1
    if (PH_ON(0)) ph_prologue(P, shm);
#endif
    PH_SYNC(0)
#if (PHMASK >> 1) & 1
    if (PH_ON(1)) { pg8::Gemm g{(const bf16_t*)(ws + OFF_XB), (const bf16_t*)(ws + OFF_WIN), NTOK, INC, DM, DM, DM, 0}; S.init(NTOK, INC, gridDim.x, blockIdx.x);
        EpiScaleBf16 E{(bf16_t*)(ws + OFF_Z), INC, ss, nullptr}; pg8::gemm_phase(lds, g, S, E); }
#endif
    PH_SYNC(1)
#if (PHMASK >> 2) & 1
    if (PH_ON(2)) { const bool first = (blockIdx.x >> 3) & 1;
        if (first) wt_convert(P, shm, 2016, 3248);
        ph_pool_diff(P); ph_ret_kv(P, shm);
        if (!first) wt_convert(P, shm, 2016, 3248); }
#endif
    PH_SYNC(2)
#if (PHMASK >> 3) & 1
    if (PH_ON(3)) { pg8::Gemm g{(const bf16_t*)(ws + OFF_DIFF), (const bf16_t*)(ws + OFF_POOLT), NTOK, 1024, 256, 1024, 256, 512}; S.init(NTOK, 1024, gridDim.x, blockIdx.x);
        EpiScaleBf16 E{(bf16_t*)(ws + OFF_MIX), DM, nullptr, P.pool_scale}; pg8::gemm_phase(lds, g, S, E); ph_ret_scan(P); }
#endif
    PH_SYNC(3)
#if (PHMASK >> 4) & 1
    if (PH_ON(4)) { const bool first = (blockIdx.x >> 3) & 1;
        if (first) wt_convert(P, shm, 640, 2016);
        ph_ret_out(P, shm);
        if (!first) wt_convert(P, shm, 640, 2016); }
#endif
    PH_SYNC(4)
#if (PHMASK >> 5) & 1
    if (PH_ON(5)) { pg8::Gemm g{(const bf16_t*)(ws + OFF_MIX), (const bf16_t*)(ws + OFF_WOUT), NTOK, DM, DM, DM, DM, 0}; S.init(NTOK, DM, gridDim.x, blockIdx.x);
        EpiRes<false> E{ws + OFF_XB, (bf16_t*)(ws + OFF_H1B), ss + NTOK}; pg8::gemm_phase(lds, g, S, E); }
#endif
    PH_SYNC(5)
#if (PHMASK >> 6) & 1
    if (PH_ON(6)) { pg8::Gemm g{(const bf16_t*)(ws + OFF_H1B), (const bf16_t*)(ws + OFF_WUP), NTOK, UPC, DM, DM, DM, 0}; S.init(NTOK, UPC, gridDim.x, blockIdx.x);
        EpiUp E{(bf16_t*)(ws + OFF_ACT), (float*)(ws + OFF_EDGE), ss + NTOK, P.conv_w, P.conv_b}; pg8::gemm_phase(lds, g, S, E); }
#endif
    PH_SYNC(6)
#if (PHMASK >> 7) & 1
    if (PH_ON(7)) ph_fixup(P);
#endif
    PH_SYNC(7)
#if (PHMASK >> 8) & 1
    if (PH_ON(8)) { pg8::Gemm g{(const bf16_t*)(ws + OFF_ACT), (const bf16_t*)(ws + OFF_WDOWN), NTOK, DM, DFF, DFF, DFF, 0}; S.init(NTOK, DM, gridDim.x, blockIdx.x);
        EpiRes<false> E{ws + OFF_H1B, (bf16_t*)(ws + OFF_H2B), ss + 2 * NTOK}; pg8::gemm_phase(lds, g, S, E); }
#endif
#if (PHMASK >> 11) & 1
    if (PH_ON(8)) { pg8::Gemm g2{(const bf16_t*)(ws + OFF_PB), (const bf16_t*)(ws + OFF_WPROJ), NTOK, DM, PLE, PLE, PLE, 0}; S.init(NTOK, DM, gridDim.x, blockIdx.x);
        EpiScaleBf16 E2{(bf16_t*)(ws + OFF_PROJ), DM, nullptr, nullptr}; pg8::gemm_phase(lds, g2, S, E2); }
#endif
    PH_SYNC(8)
#if (PHMASK >> 9) & 1
    if (PH_ON(9)) { pg8::Gemm g{(const bf16_t*)(ws + OFF_H2B), (const bf16_t*)(ws + OFF_WGATE), NTOK, DM, DM, DM, DM, 0}; S.init(NTOK, DM, gridDim.x, blockIdx.x);
        EpiGate E{(const bf16_t*)(ws + OFF_H2B), (bf16_t*)(ws + OFF_H3B), (const bf16_t*)(ws + OFF_PROJ), ss + 2 * NTOK, ss + 3 * NTOK}; pg8::gemm_phase(lds, g, S, E); }
#endif
    PH_SYNC(9)
#if (PHMASK >> 10) & 1
    if (PH_ON(10)) ph_final(P);
#endif
    if (P.ph_hi > 1000) cg::this_grid().sync();
}

constexpr int NPHASES = 11;

extern "C" void kernel_launch(void* const* d_in, const int* in_sizes, int n_in, void* d_out, int out_size, void* d_ws, size_t ws_size, hipStream_t stream) {
    (void)in_sizes; (void)n_in; (void)out_size; (void)ws_size;
    static int grid_blocks = 0;
    if (!grid_blocks) {
        (void)hipFuncSetAttribute((const void*)fwd_megakernel, hipFuncAttributeMaxDynamicSharedMemorySize, LDS_BYTES);
        int dev = 0, cus = 0, per_cu = 0;
        (void)hipGetDevice(&dev);
        (void)hipDeviceGetAttribute(&cus, hipDeviceAttributeMultiprocessorCount, dev);
        (void)hipOccupancyMaxActiveBlocksPerMultiprocessor(&per_cu, fwd_megakernel, 512, LDS_BYTES);
        if (per_cu < 1) per_cu = 1;
        if (per_cu > 1) per_cu = 1;
        grid_blocks = cus * per_cu;
    }
    Params P;
    memset(&P, 0, sizeof(P));
    P.x = (const float*)d_in[0]; P.p = (const float*)d_in[1]; P.norm1_w = (const float*)d_in[2]; P.w_in = (const float*)d_in[3];
    P.pool_w = (const float*)d_in[4]; P.pool_scale = (const float*)d_in[5]; P.ret_gn_w = (const float*)d_in[6]; P.w_out = (const float*)d_in[7];
    P.norm2_w = (const float*)d_in[8]; P.w_up = (const float*)d_in[9]; P.conv_w = (const float*)d_in[10]; P.conv_b = (const float*)d_in[11];
    P.w_down = (const float*)d_in[12]; P.norm3_w = (const float*)d_in[13]; P.ple_gate_w = (const float*)d_in[14]; P.ple_proj_w = (const float*)d_in[15];
    P.final_norm_w = (const float*)d_in[16];
    P.out = (float*)d_out; P.ws = (unsigned char*)d_ws;
    for (int i = 0; i < 64; ++i) { const float e = (float)(2 * i) / 128.0f; const float pw = powf(10000.0f, e); P.inv_freq[i] = 1.0f / pw; }
    for (int h = 0; h < 8; ++h) { const float gamma = 1.0f - exp2f(-5.0f - (float)h); P.log2g[h] = (float)std::log2((double)gamma); }
#if MK_SINGLE
    P.ph_lo = 0; P.ph_hi = NPHASES;
    void* args[] = {(void*)&P};
    (void)hipMemsetAsync((unsigned char*)d_ws + OFF_BAR, 0, XCD_BAR_WORDS * 4, stream);
    hipError_t e = hipLaunchCooperativeKernel((const void*)fwd_megakernel, dim3(grid_blocks), dim3(512), args, LDS_BYTES, stream);
    if (e != hipSuccess) fprintf(stderr, "cooperative launch failed: %s (grid %d)\n", hipGetErrorString(e), grid_blocks);
#else
    for (int ph = 0; ph < NPHASES; ++ph) {
        P.ph_lo = ph; P.ph_hi = ph + 1;
        hipLaunchKernelGGL(fwd_megakernel, dim3(grid_blocks), dim3(512), LDS_BYTES, stream, P);
    }
#endif
}
```
